# Optimizing an MI355X kernel written in HIP

```python
import math
import jax, jax.numpy as jnp
from jax import lax
import numpy as np

D_MODEL = 1024
BATCH = 8
SEQ = 4096
DEPTH = 4

CHUNK = 64
EPS = 1e-6

S5_WIDTH = D_MODEL // 2
S5_GROUP = 16
S5_GROUPS = S5_WIDTH // S5_GROUP
S5_STATE = 64
DT_MIN = 1e-3
DT_MAX = 1e-1

GLA_HEADS = 4
GLA_KEY = D_MODEL // 2
GLA_VAL = D_MODEL
GLA_DK = GLA_KEY // GLA_HEADS
GLA_DV = GLA_VAL // GLA_HEADS
GLA_GATE_RANK = 16
GLA_GATE_TEMP = 16.0

D_FF = -(-8 * D_MODEL // (3 * 256)) * 256

IN_PROJ_SIZES = (S5_WIDTH, GLA_KEY, GLA_KEY, GLA_VAL, GLA_VAL, GLA_GATE_RANK, D_MODEL, D_MODEL)
D_IN_PROJ = S5_WIDTH + 2 * GLA_KEY + 2 * GLA_VAL + GLA_GATE_RANK + 2 * D_MODEL

kernel_name = "hybrid_s5_gla_gated_merge_trunk"


def rms_norm(x, g):
    x32 = x.astype(jnp.float32)
    y = x32 * lax.rsqrt(jnp.mean(x32 * x32, axis=-1, keepdims=True) + EPS)
    return (y * g.astype(jnp.float32)).astype(x.dtype)


def s5_branch(u, a_re, a_im, log_dt, b_re, b_im, c_re, c_im, d_skip, w_glu):
    f32 = jnp.float32
    bsz, seq, _ = u.shape
    u32 = u.astype(f32).reshape(bsz, seq, S5_GROUPS, S5_GROUP)
    a = lax.complex(a_re.astype(f32), a_im.astype(f32))
    dt = jnp.exp(log_dt.astype(f32))[:, None]
    a_bar = jnp.exp(a * dt)
    b = lax.complex(b_re.astype(f32), b_im.astype(f32))
    b_bar = ((a_bar - 1.0) / a)[..., None] * b
    bu = jnp.einsum('blgc,gpc->blgp', u32.astype(jnp.complex64), b_bar)
    decay = jnp.broadcast_to(a_bar, bu.shape)

    def combine(left, right):
        a_l, b_l = left
        a_r, b_r = right
        return a_r * a_l, a_r * b_l + b_r

    _, states = lax.associative_scan(combine, (decay, bu), axis=1)
    c = lax.complex(c_re.astype(f32), c_im.astype(f32))
    y = jnp.real(jnp.einsum('blgp,gcp->blgc', states, c)) \
        + d_skip.astype(f32).reshape(S5_GROUPS, S5_GROUP) * u32
    y = jax.nn.gelu(y.reshape(bsz, seq, S5_WIDTH))
    val, gate = jnp.split(y @ w_glu.astype(f32), 2, axis=-1)
    return (val * jax.nn.sigmoid(gate)).astype(u.dtype)


def gla_branch(q, k, v, g, a_low, w_gate_up, b_gate, head_norm_g):
    f32 = jnp.float32
    out_dtype = v.dtype
    bsz, seq, _ = q.shape
    n_chunks = seq // CHUNK

    def chunked(t, d):
        return t.astype(f32).reshape(bsz, n_chunks, CHUNK, GLA_HEADS, d)

    qc = chunked(q, GLA_DK) * (GLA_DK ** -0.5)
    kc = chunked(k, GLA_DK)
    vc = chunked(v, GLA_DV)
    log_alpha = jax.nn.log_sigmoid(a_low.astype(f32) @ w_gate_up.astype(f32)
                                   + b_gate.astype(f32)) / GLA_GATE_TEMP
    log_alpha = chunked(log_alpha, GLA_DK)
    cum = jnp.cumsum(log_alpha, axis=2)
    total = cum[:, :, -1:]
    k_end = kc * jnp.exp(total - cum)

    scores = jnp.einsum('bcqhk,bcshk->bchqs', qc, k_end)
    intra = jnp.einsum('bchqs,bcshv->bcqhv', scores, vc)

    kv = jnp.einsum('bcshk,bcshv->bchkv', k_end, vc)
    chunk_decay = jnp.exp(total[:, :, 0])

    def step(state, xs):
        dec, kv_c = xs
        return dec[..., None] * state + kv_c, state

    init = jnp.zeros((bsz, GLA_HEADS, GLA_DK, GLA_DV), f32)
    _, prev = lax.scan(step, init, (jnp.moveaxis(chunk_decay, 1, 0), jnp.moveaxis(kv, 1, 0)))
    prev = jnp.moveaxis(prev, 0, 1)
    inter = jnp.einsum('bcqhk,bchkv->bcqhv', qc * jnp.exp(total), prev)

    o = intra + inter
    o = o * lax.rsqrt(jnp.mean(o * o, axis=-1, keepdims=True) + EPS)
    o = o * head_norm_g.astype(f32).reshape(GLA_HEADS, GLA_DV)
    o = o.reshape(bsz, seq, GLA_VAL) * jax.nn.silu(g.astype(f32))
    return o.astype(out_dtype)


def setup_inputs(seed: int = 0) -> dict:
    key = jax.random.key(seed)
    ks = jax.random.split(key, 24)
    f32 = jnp.float32
    nrm = lambda k, shape, scale: scale * jax.random.normal(k, shape, f32)
    gain = lambda k, shape: 1.0 + 0.02 * jax.random.normal(k, shape, f32)
    a_im_init = jnp.pi * jnp.arange(S5_STATE, dtype=f32)
    return {
        "x": jax.random.normal(ks[0], (BATCH, SEQ, D_MODEL), f32),
        "attn_norm_g": gain(ks[1], (DEPTH, D_MODEL)),
        "w_in": nrm(ks[2], (DEPTH, D_MODEL, D_IN_PROJ), D_MODEL ** -0.5),
        "s5_a_re": -0.5 + 0.01 * jax.random.normal(ks[3], (DEPTH, S5_GROUPS, S5_STATE), f32),
        "s5_a_im": a_im_init + 0.01 * jax.random.normal(ks[4], (DEPTH, S5_GROUPS, S5_STATE), f32),
        "s5_log_dt": jax.random.uniform(ks[5], (DEPTH, S5_GROUPS), f32,
                                        minval=math.log(DT_MIN), maxval=math.log(DT_MAX)),
        "s5_b_re": nrm(ks[6], (DEPTH, S5_GROUPS, S5_STATE, S5_GROUP), (2 * S5_GROUP) ** -0.5),
        "s5_b_im": nrm(ks[7], (DEPTH, S5_GROUPS, S5_STATE, S5_GROUP), (2 * S5_GROUP) ** -0.5),
        "s5_c_re": nrm(ks[8], (DEPTH, S5_GROUPS, S5_GROUP, S5_STATE), S5_STATE ** -0.5),
        "s5_c_im": nrm(ks[9], (DEPTH, S5_GROUPS, S5_GROUP, S5_STATE), S5_STATE ** -0.5),
        "s5_d": nrm(ks[10], (DEPTH, S5_WIDTH), 1.0),
        "s5_w_glu": nrm(ks[11], (DEPTH, S5_WIDTH, 2 * S5_WIDTH), S5_WIDTH ** -0.5),
        "gla_w_gate_up": nrm(ks[12], (DEPTH, GLA_GATE_RANK, GLA_KEY), GLA_GATE_RANK ** -0.5),
        "gla_b_gate": nrm(ks[13], (DEPTH, GLA_KEY), 0.1),
        "gla_head_norm_g": gain(ks[14], (DEPTH, GLA_VAL)),
        "w_branch_s5": nrm(ks[15], (DEPTH, S5_WIDTH, D_MODEL), S5_WIDTH ** -0.5),
        "w_branch_gla": nrm(ks[16], (DEPTH, GLA_VAL, D_MODEL), GLA_VAL ** -0.5),
        "w_out": nrm(ks[17], (DEPTH, D_MODEL, D_MODEL), D_MODEL ** -0.5),
        "ffn_norm_g": gain(ks[18], (DEPTH, D_MODEL)),
        "w_ffn_gate": nrm(ks[19], (DEPTH, D_MODEL, D_FF), D_MODEL ** -0.5),
        "w_ffn_up": nrm(ks[20], (DEPTH, D_MODEL, D_FF), D_MODEL ** -0.5),
        "w_ffn_down": nrm(ks[21], (DEPTH, D_FF, D_MODEL), D_FF ** -0.5),
        "final_norm_g": gain(ks[22], (D_MODEL,)),
    }


def reference(x, attn_norm_g, w_in, s5_a_re, s5_a_im, s5_log_dt, s5_b_re, s5_b_im, s5_c_re, s5_c_im,
              s5_d, s5_w_glu, gla_w_gate_up, gla_b_gate, gla_head_norm_g, w_branch_s5, w_branch_gla,
              w_out, ffn_norm_g, w_ffn_gate, w_ffn_up, w_ffn_down, final_norm_g):
    split_points = [int(p) for p in np.cumsum(IN_PROJ_SIZES)[:-1]]
    h = x
    for layer in range(DEPTH):
        xn = rms_norm(h, attn_norm_g[layer])
        proj = xn @ w_in[layer]
        u, q, k, v, g, a_low, gate_s5, gate_gla = jnp.split(proj, split_points, axis=-1)
        y_s5 = s5_branch(u, s5_a_re[layer], s5_a_im[layer], s5_log_dt[layer], s5_b_re[layer],
                         s5_b_im[layer], s5_c_re[layer], s5_c_im[layer], s5_d[layer], s5_w_glu[layer])
        y_gla = gla_branch(q, k, v, g, a_low, gla_w_gate_up[layer], gla_b_gate[layer],
                           gla_head_norm_g[layer])
        mixed = jax.nn.sigmoid(gate_s5) * (y_s5 @ w_branch_s5[layer]) \
            + jax.nn.sigmoid(gate_gla) * (y_gla @ w_branch_gla[layer])
        h = h + mixed @ w_out[layer]
        hn = rms_norm(h, ffn_norm_g[layer])
        h = h + (jax.nn.silu(hn @ w_ffn_gate[layer]) * (hn @ w_ffn_up[layer])) @ w_ffn_down[layer]
    return rms_norm(h, final_norm_g)
```

```cpp
#include <hip/hip_runtime.h>
#include <hip/hip_cooperative_groups.h>
#include <cstdio>
#include <cstdint>
namespace cg = cooperative_groups;

#define LAS __attribute__((address_space(3)))
typedef unsigned short bf16_t;
typedef short bf16x8 __attribute__((ext_vector_type(8)));
typedef float f32x4 __attribute__((ext_vector_type(4)));
typedef float f32x2 __attribute__((ext_vector_type(2)));
typedef unsigned u32x4 __attribute__((ext_vector_type(4)));
typedef unsigned u32x2 __attribute__((ext_vector_type(2)));

constexpr int DM = 1024, MTOK = 32768, MH = 16384, DEPTH = 4, DIN = 5648, NPROJ = 6144, DFF = 2816;
constexpr int NTHR = 512;
constexpr float EPS = 1e-6f;
constexpr size_t MiB = 1u << 20;
constexpr size_t WS_WIN = 1 * MiB, WS_WGLU = 13 * MiB, WS_WMRG = 14 * MiB, WS_WOUT = 17 * MiB, WS_WGU = 19 * MiB, WS_WDN = 30 * MiB;
constexpr size_t WS_BTY = 36 * MiB, WS_BTZ = 42 * MiB, WS_LAM = 46 * MiB;
constexpr size_t WS_WALOW = 46 * MiB + 65536;
constexpr size_t WS_WG2 = 46 * MiB + 131072;
constexpr size_t WS_XN = 48 * MiB;
constexpr size_t WS_U = 112 * MiB, WS_SU = 144 * MiB, WS_Q = 176 * MiB, WS_KB = 208 * MiB, WS_LA = 240 * MiB, WS_VY = 272 * MiB;
constexpr size_t WS_SG = 368 * MiB, WS_Z = 432 * MiB, WS_KV = 464 * MiB, WS_DEC = 496 * MiB;
constexpr size_t WS_R = 144 * MiB, WS_GG = 208 * MiB;
constexpr size_t WS_MIX = 368 * MiB;
constexpr size_t WS_H = 112 * MiB;
constexpr size_t WS_DECC = 497 * MiB;
constexpr size_t WS_END = 498 * MiB;
constexpr int LDS_BYTES = 147456;

__device__ __forceinline__ int ltid_w(int wv) { int t; asm volatile("v_mbcnt_lo_u32_b32 %0, -1, 0\n\tv_mbcnt_hi_u32_b32 %0, -1, %0\n\tv_lshl_or_b32 %0, %1, 6, %0" : "=&v"(t) : "s"(wv)); return t; }
#define ltid() ltid_w(WV)
__device__ __forceinline__ unsigned cvt_pk_bf16(float lo, float hi) { unsigned r; asm volatile("v_cvt_pk_bf16_f32 %0, %1, %2" : "=v"(r) : "v"(lo), "v"(hi)); return r; }
#define MFMA_SETTLE() do { __builtin_amdgcn_sched_barrier(0); asm volatile("s_nop 15\n\ts_nop 7" ::: "memory"); __builtin_amdgcn_sched_barrier(0); } while (0)
__device__ __forceinline__ float bf2f(unsigned short b) { return __uint_as_float(((unsigned)b) << 16); }
__device__ __forceinline__ float bflo(unsigned w) { return __uint_as_float(w << 16); }
__device__ __forceinline__ float bfhi(unsigned w) { return __uint_as_float(w & 0xffff0000u); }
__device__ __forceinline__ unsigned short f2bf(float f) { unsigned u = __float_as_uint(f); u += 0x7fffu + ((u >> 16) & 1u); return (unsigned short)(u >> 16); }
__device__ __forceinline__ float sigm(float x) { return __builtin_amdgcn_rcpf(1.0f + __expf(-x)); }
__device__ __forceinline__ float silu_f(float x) { return x * __builtin_amdgcn_rcpf(1.0f + __expf(-x)); }
__device__ __forceinline__ float gelu_tanh(float x) { const float t = 1.5957691216f * (x + 0.044715f * x * x * x); return x * __builtin_amdgcn_rcpf(1.0f + __expf(-t)); }
__device__ __forceinline__ float logsig(float x) { return fminf(x, 0.f) - 0.69314718056f * __builtin_amdgcn_logf(1.0f + __builtin_amdgcn_exp2f(-1.44269504089f * fabsf(x))); }
__device__ __forceinline__ unsigned pk_h2(float a, float b) { const _Float16 ha = (_Float16)a, hb = (_Float16)b; return (unsigned)__builtin_bit_cast(unsigned short, ha) | ((unsigned)__builtin_bit_cast(unsigned short, hb) << 16); }
__device__ __forceinline__ float h2f(unsigned short h) { return (float)__builtin_bit_cast(_Float16, h); }
__device__ __forceinline__ u32x4 pack8(f32x4 a, f32x4 b) { u32x4 r; r[0] = cvt_pk_bf16(a[0], a[1]); r[1] = cvt_pk_bf16(a[2], a[3]); r[2] = cvt_pk_bf16(b[0], b[1]); r[3] = cvt_pk_bf16(b[2], b[3]); return r; }

namespace pg8 {
constexpr int BM = 256, BK = 64, HALF = 128, HTB = HALF * BK * 2, STAGE_BYTES = 8 * HTB, NXCD = 8, WGM = 8;
__host__ __device__ __forceinline__ int lds_byte(int r, int c) { const int st = (r >> 4) * 2 + (c >> 5), rr = r & 15, cc = c & 31, ob = rr * 64 + cc * 2; return st * 1024 + (ob ^ (((ob >> 9) & 1) << 5)); }
__host__ __device__ __forceinline__ void stage_rc(int b, int& R, int& C) { const int st = b / 1024, sb = b % 1024, swz = sb ^ (((sb >> 9) & 1) << 5); R = (st >> 1) * 16 + swz / 64; C = (st & 1) * 32 + (swz % 64) / 2; }
__host__ __device__ __forceinline__ int perm32(int rho) { const int n = rho >> 4, i = rho & 15; return 8 * (i >> 2) + 4 * n + (i & 3); }

struct Unit { int pm, pn; };
struct Gemm { const char* A; const char* A2; const char* Bt; int M, N, K, lda, ldb, seg, apn, tsw; };

struct StaticOrder {
    int nM, nN, nwg, G, c;
    __device__ __forceinline__ void init(int M, int N, int G_, int c_) { nM = M / BM; nN = N / BM; nwg = nM * nN; G = G_; c = c_; }
    __device__ bool next(int i, Unit& u) const {
        const long L = (long)i * G + c; if (L >= nwg) return false;
        int wgid = (int)L; { const int q = nwg / NXCD, r = nwg % NXCD, xcd = wgid % NXCD, off = wgid / NXCD; wgid = (xcd < r ? xcd * (q + 1) : r * (q + 1) + (xcd - r) * q) + off; }
        const int nig = WGM * nN, gid = wgid / nig, fm = gid * WGM, gsz = (nM - fm) < WGM ? (nM - fm) : WGM;
        u.pm = fm + ((wgid % nig) % gsz); u.pn = (wgid % nig) / gsz; return true;
    }
};

template <class Epi>
__device__ __forceinline__ void gemm_phase(const int WV, LAS unsigned char* lds, const Gemm g, const StaticOrder& S, const Epi& E) {
    const int tid = ltid(), wid = __builtin_amdgcn_readfirstlane(tid >> 6), lane = tid & 63, wr = wid >> 2, wc = wid & 3, fr = lane & 15, fq = lane >> 4;
    const int K = g.K, nt = K / BK;
    const int rsA = g.seg ? 8192 : g.lda;
    unsigned voffA[2], voffB[2];
#pragma unroll
    for (int i = 0; i < 2; ++i) { int R, C; stage_rc(tid * 16 + i * 8192, R, C); const int Rb = Epi::PERM ? ((R & ~31) + perm32(R & 31)) : R;
        voffA[i] = g.seg ? (unsigned)(R * 8192 + (C >> 4) * 512 + (C & 15)) * 2u : (unsigned)(R * g.lda + C) * 2u;
        voffB[i] = (unsigned)(Rb * g.ldb + C) * 2u; }
    const size_t kstepA = g.seg ? (size_t)4096 : (size_t)(BK * 2);
    const size_t kstepB = (size_t)(BK * 2);
    const size_t hstepA = (size_t)HALF * rsA * 2, tstepA = 2 * hstepA;
    const size_t hstepB = (size_t)HALF * g.ldb * 2, tstepB = 2 * hstepB;
    const int tsw = g.tsw;
    const unsigned ldsw = (unsigned)wid * 1024u;
    const int aoff = lds_byte(wr * 64 + fr, fq * 8), boff = lds_byte(wc * 32 + fr, fq * 8);
#define PG8_SA(b, h) (((b) * 2 + (h)) * HTB)
#define PG8_SB(b, h) ((4 + (b) * 2 + (h)) * HTB)
#define PG8_STAGE(bufoff, gbase, voff) do { _Pragma("unroll") for (int _i = 0; _i < 2; ++_i) \
        __builtin_amdgcn_global_load_lds((const unsigned*)((const char*)(gbase) + (voff)[_i]), (LAS unsigned*)(lds + (bufoff) + ldsw + _i * 8192), 16, 0, 0); } while (0)
#define PG8_LDA(dst, b, h) do { _Pragma("unroll") for (int m = 0; m < 4; ++m) _Pragma("unroll") for (int k = 0; k < 2; ++k) dst[m][k] = *(const LAS bf16x8*)(lds + PG8_SA(b, h) + aoff + m * 2048 + k * 1024); } while (0)
#define PG8_LDB(dst, b, h) do { _Pragma("unroll") for (int n = 0; n < 2; ++n) _Pragma("unroll") for (int k = 0; k < 2; ++k) dst[n][k] = *(const LAS bf16x8*)(lds + PG8_SB(b, h) + boff + n * 2048 + k * 1024); } while (0)
#define PG8_MMA(ai, bj, At, Bt) do { __builtin_amdgcn_s_setprio(1); _Pragma("unroll") for (int m = 0; m < 4; ++m) _Pragma("unroll") for (int n = 0; n < 2; ++n) _Pragma("unroll") for (int k = 0; k < 2; ++k) \
        acc[ai][bj][m][n] = __builtin_amdgcn_mfma_f32_16x16x32_bf16(Bt[n][k], At[m][k], acc[ai][bj][m][n], 0, 0, 0); __builtin_amdgcn_s_setprio(0); } while (0)
#define PG8_WAIT_V(n) asm volatile("s_waitcnt vmcnt(" #n ")" ::: "memory")
#define PG8_WAIT_L(n) asm volatile("s_waitcnt lgkmcnt(" #n ")" ::: "memory")
#define PG8_BAR __builtin_amdgcn_s_barrier()
#define PG8_SCHED __builtin_amdgcn_sched_barrier(0)
    Unit cur, nxt; int ui = 0;
    if (!S.next(0, cur)) return;
    f32x4 acc[2][2][4][2];
    float zf; asm volatile("v_mov_b32 %0, 0" : "=v"(zf));
#pragma unroll
    for (int a = 0; a < 2; ++a)
#pragma unroll
        for (int b = 0; b < 2; ++b)
#pragma unroll
            for (int m = 0; m < 4; ++m)
#pragma unroll
                for (int n = 0; n < 2; ++n) acc[a][b][m][n] = (f32x4){zf, zf, zf, zf};
    bf16x8 At[4][2], B0[2][2], B1[2][2];
    size_t offA = (size_t)cur.pm * tstepA + (size_t)cur.pn * g.apn;
    const char* cA = g.A + offA; const char* cA2 = g.A2 + offA; const char* cB = g.Bt + (size_t)cur.pn * tstepB;
    PG8_STAGE(PG8_SB(0, 0), cB, voffB); PG8_STAGE(PG8_SB(0, 1), cB + hstepB, voffB); PG8_STAGE(PG8_SA(0, 0), cA, voffA); PG8_STAGE(PG8_SA(0, 1), cA + hstepA, voffA);
    if (wr == 1) PG8_BAR;
    PG8_WAIT_V(2); PG8_BAR;
    PG8_STAGE(PG8_SB(1, 0), cB + kstepB, voffB); PG8_STAGE(PG8_SA(1, 0), cA + kstepA, voffA); PG8_STAGE(PG8_SB(1, 1), cB + hstepB + kstepB, voffB);
    PG8_WAIT_V(6); PG8_BAR;
    for (;;) {
        const bool has_next = S.next(ui + 1, nxt);
        const size_t noffA = has_next ? (size_t)nxt.pm * tstepA + (size_t)nxt.pn * g.apn : offA;
        const char* nA = g.A + noffA; const char* nB = has_next ? g.Bt + (size_t)nxt.pn * tstepB : cB;
        for (int t = 0; t < nt; t += 2) {
            const bool last = (t == nt - 2);
            if constexpr (Epi::MID) { if (t == Epi::TMID) { MFMA_SETTLE(); const int t_e = ltid(); const int fr_e = t_e & 15, fq_e = (t_e >> 4) & 3; E.mid(acc, cur, wr, wc, fr_e, fq_e); } }
            const char* a1 = ((t + 1) < tsw ? cA : cA2) + (size_t)(t + 1) * kstepA;
            const char* a2 = last ? nA : ((t + 2) < tsw ? cA : cA2) + (size_t)(t + 2) * kstepA;
            const char* a3 = last ? nA + kstepA : ((t + 3) < tsw ? cA : cA2) + (size_t)(t + 3) * kstepA;
            const char* b2 = last ? nB : cB + (size_t)(t + 2) * kstepB;
            const char* b3 = b2 + kstepB;
            PG8_LDB(B0, 0, 0); PG8_LDB(B1, 0, 1); PG8_SCHED; PG8_LDA(At, 0, 0); PG8_STAGE(PG8_SA(1, 1), a1 + hstepA, voffA);
            PG8_WAIT_V(8); PG8_WAIT_L(0); PG8_BAR; PG8_MMA(0, 0, At, B0); PG8_MMA(0, 1, At, B1); PG8_BAR; PG8_SCHED;
            PG8_LDA(At, 0, 1); PG8_STAGE(PG8_SB(0, 0), b2, voffB); PG8_STAGE(PG8_SB(0, 1), b2 + hstepB, voffB); PG8_STAGE(PG8_SA(0, 0), a2, voffA);
            PG8_WAIT_V(8); PG8_WAIT_L(0); PG8_BAR; PG8_MMA(1, 0, At, B0); PG8_MMA(1, 1, At, B1); PG8_BAR; PG8_SCHED;
            PG8_LDB(B0, 1, 0); PG8_LDB(B1, 1, 1); PG8_SCHED; PG8_LDA(At, 1, 0); PG8_STAGE(PG8_SA(0, 1), a2 + hstepA, voffA);
            PG8_WAIT_V(8); PG8_WAIT_L(0); PG8_BAR; PG8_MMA(0, 0, At, B0); PG8_MMA(0, 1, At, B1); PG8_BAR; PG8_SCHED;
            PG8_LDA(At, 1, 1); PG8_STAGE(PG8_SB(1, 0), b3, voffB); PG8_STAGE(PG8_SB(1, 1), b3 + hstepB, voffB); PG8_STAGE(PG8_SA(1, 0), a3, voffA);
            PG8_WAIT_V(8); PG8_WAIT_L(0); PG8_BAR; PG8_MMA(1, 0, At, B0); PG8_MMA(1, 1, At, B1); PG8_BAR; PG8_SCHED;
        }
        if (wr == 0) PG8_BAR;
        MFMA_SETTLE();
        { const int t_e = ltid(); const int fr_e = t_e & 15, fq_e = (t_e >> 4) & 3; E(acc, cur, wr, wc, fr_e, fq_e); }
        if (!has_next) break;
#pragma unroll
        for (int a = 0; a < 2; ++a)
#pragma unroll
            for (int b = 0; b < 2; ++b)
#pragma unroll
                for (int m = 0; m < 4; ++m)
#pragma unroll
                    for (int n = 0; n < 2; ++n) acc[a][b][m][n] = (f32x4){zf, zf, zf, zf};
        cur = nxt; offA = noffA; cA = nA; cA2 = g.A2 + noffA; cB = nB; ++ui;
        if (wr == 1) PG8_BAR;
    }
    PG8_WAIT_V(0);
    PG8_BAR;
#undef PG8_SA
#undef PG8_SB
#undef PG8_STAGE
#undef PG8_LDA
#undef PG8_LDB
#undef PG8_MMA
#undef PG8_WAIT_V
#undef PG8_WAIT_L
#undef PG8_BAR
#undef PG8_SCHED
}
}
using pg8::Unit;
typedef f32x4 Acc[2][2][4][2];

struct Args { const float* in[23]; float* out; unsigned char* ws; };
typedef const __attribute__((address_space(4))) char* kptr_t;
__device__ __forceinline__ kptr_t kbase() { kptr_t k = (kptr_t)__builtin_amdgcn_kernarg_segment_ptr(); asm volatile("" : "+s"(k)); return k; }
__device__ __forceinline__ const float* inp(int i) { return *(const float* const __attribute__((address_space(4)))*)(kbase() + 8 * i); }
__device__ __forceinline__ float* outp() { return *(float* const __attribute__((address_space(4)))*)(kbase() + 8 * 23); }
__device__ __forceinline__ unsigned char* wsp() { return *(unsigned char* const __attribute__((address_space(4)))*)(kbase() + 8 * 24); }


struct EpiG1 {
    static constexpr bool PERM = true, MID = false; static constexpr int TMID = 0;
    int L;
    __device__ __forceinline__ void mid(Acc&, const Unit&, int, int, int, int) const {}
    __device__ __forceinline__ void operator()(const Acc& acc, const Unit& u, int wr, int wc, int fr, int fq) const {
        const int pn = u.pn, row0 = u.pm * 256 + wr * 64 + fr, cw = wc * 32 + 8 * fq;
        unsigned char* const wsb = wsp();
        if (pn < 14) {
            bf16_t* base; int ld; bool dosilu = false;
            if (pn < 2) { base = (bf16_t*)(wsb + WS_U) + pn * 256; ld = 512; }
            else if (pn < 4) { base = (bf16_t*)(wsb + WS_Q) + (pn - 2) * 256; ld = 512; }
            else if (pn < 6) { base = (bf16_t*)(wsb + WS_KB) + (pn - 4) * 256; ld = 512; }
            else if (pn < 10) { base = (bf16_t*)(wsb + WS_VY) + 512 + (pn - 6) * 256; ld = 1536; }
            else { base = (bf16_t*)(wsb + WS_SG) + (pn - 10) * 256; ld = 1024; dosilu = true; }
#pragma unroll
            for (int ai = 0; ai < 2; ++ai)
#pragma unroll
                for (int m = 0; m < 4; ++m) { bf16_t* rowp = base + (size_t)(row0 + ai * 128 + m * 16) * ld + cw;
#pragma unroll
                    for (int bj = 0; bj < 2; ++bj) { f32x4 v0 = acc[ai][bj][m][0], v1 = acc[ai][bj][m][1];
                        if (dosilu) {
#pragma unroll
                            for (int e = 0; e < 4; ++e) { v0[e] = silu_f(v0[e]); v1[e] = silu_f(v1[e]); } }
                        *(u32x4*)(rowp + bj * 128) = pack8(v0, v1); __builtin_amdgcn_sched_barrier(0); } }
        } else {
            const int c0 = (pn - 14) * 256 + cw; const float* const bgate = inp(13) + L * 512; unsigned short* const LA = (unsigned short*)(wsb + WS_LA);
#pragma unroll
            for (int bj = 0; bj < 2; ++bj) { const f32x4 b0 = *(const f32x4*)(bgate + c0 + bj * 128), b1 = *(const f32x4*)(bgate + c0 + bj * 128 + 4);
#pragma unroll
                for (int ai = 0; ai < 2; ++ai)
#pragma unroll
                    for (int m = 0; m < 4; ++m) { const f32x4 v0 = acc[ai][bj][m][0] + b0, v1 = acc[ai][bj][m][1] + b1; u32x4 o;
                        o[0] = pk_h2(logsig(v0[0]) * 0.0625f, logsig(v0[1]) * 0.0625f); o[1] = pk_h2(logsig(v0[2]) * 0.0625f, logsig(v0[3]) * 0.0625f);
                        o[2] = pk_h2(logsig(v1[0]) * 0.0625f, logsig(v1[1]) * 0.0625f); o[3] = pk_h2(logsig(v1[2]) * 0.0625f, logsig(v1[3]) * 0.0625f);
                        *(u32x4*)(LA + (size_t)(row0 + ai * 128 + m * 16) * 512 + c0 + bj * 128) = o; __builtin_amdgcn_sched_barrier(0); } }
        }
    }
};
struct EpiGate {
    static constexpr bool PERM = true, MID = false; static constexpr int TMID = 0;
    int dummy;
    __device__ __forceinline__ void mid(Acc&, const Unit&, int, int, int, int) const {}
    __device__ __forceinline__ void operator()(const Acc& acc, const Unit& u, int wr, int wc, int fr, int fq) const {
        const int row0 = u.pm * 256 + wr * 64 + fr, cw = wc * 32 + 8 * fq;
        unsigned char* const wsb = wsp();
        {
            const int T = u.pn; bf16_t* const R = (bf16_t*)(wsb + WS_R); bf16_t* const GG = (bf16_t*)(wsb + WS_GG);
#pragma unroll
            for (int ai = 0; ai < 2; ++ai)
#pragma unroll
                for (int m = 0; m < 4; ++m) { const size_t o = (size_t)(row0 + ai * 128 + m * 16) * 1024 + T * 128 + cw;
                    f32x4 r0, r1, g0, g1;
#pragma unroll
                    for (int e = 0; e < 4; ++e) {
                        const float ea0 = __expf(-acc[ai][0][m][0][e]), eb0 = __expf(-acc[ai][1][m][0][e]);
                        const float ea1 = __expf(-acc[ai][0][m][1][e]), eb1 = __expf(-acc[ai][1][m][1][e]);
                        const float ta0 = 1.0f + ea0, tb0 = 1.0f + eb0, ta1 = 1.0f + ea1, tb1 = 1.0f + eb1;
                        const float q0 = __builtin_amdgcn_rcpf(ta0 * tb0), q1 = __builtin_amdgcn_rcpf(ta1 * tb1);
                        g0[e] = q0 * ta0; g1[e] = q1 * ta1; r0[e] = q0 * tb0 * tb0; r1[e] = q1 * tb1 * tb1; }
                    *(u32x4*)(R + o) = pack8(r0, r1); *(u32x4*)(GG + o) = pack8(g0, g1); __builtin_amdgcn_sched_barrier(0); }
        }
    }
};
struct EpiZ {
    static constexpr bool PERM = false, MID = false; static constexpr int TMID = 0;
    int dummy;
    __device__ __forceinline__ void mid(Acc&, const Unit&, int, int, int, int) const {}
    __device__ __forceinline__ void operator()(const Acc& acc, const Unit& u, int wr, int wc, int fr, int fq) const {
        float* const Z = (float*)(wsp() + WS_Z);
        const int g = u.pn, row0 = u.pm * 256 + wr * 64 + fr, c0 = wc * 32 + 4 * fq;
#pragma unroll
        for (int ai = 0; ai < 2; ++ai)
#pragma unroll
            for (int m = 0; m < 4; ++m) { float* p = Z + ((size_t)(row0 + ai * 128 + m * 16) * 32 + g) * 128 + c0;
#pragma unroll
                for (int n = 0; n < 2; ++n) *(f32x4*)(p + n * 16) = acc[ai][0][m][n]; }
    }
};
struct EpiY {
    static constexpr bool PERM = true, MID = false; static constexpr int TMID = 0;
    int L;
    __device__ __forceinline__ void mid(Acc&, const Unit&, int, int, int, int) const {}
    __device__ __forceinline__ void operator()(const Acc& acc, const Unit& u, int wr, int wc, int fr, int fq) const {
        const int g = u.pn, row0 = u.pm * 256 + wr * 64 + fr, c0 = 8 * (fq & 1);
        bf16_t* const U = (bf16_t*)(wsp() + WS_U); const float* const D = inp(10) + L * 512;
        const f32x4 d0 = *(const f32x4*)(D + g * 16 + c0), d1 = *(const f32x4*)(D + g * 16 + c0 + 4);
#pragma unroll
        for (int ai = 0; ai < 2; ++ai) {
            u32x4 uv[4][2];
#pragma unroll
            for (int m = 0; m < 4; ++m)
#pragma unroll
                for (int bj = 0; bj < 2; ++bj) uv[m][bj] = *(const u32x4*)(U + (size_t)(16 * (row0 + ai * 128 + m * 16) + 8 * bj + 2 * wc + (fq >> 1)) * 512 + g * 16 + c0);
            __builtin_amdgcn_sched_barrier(0);
#pragma unroll
            for (int m = 0; m < 4; ++m)
#pragma unroll
                for (int bj = 0; bj < 2; ++bj) { bf16_t* p = U + (size_t)(16 * (row0 + ai * 128 + m * 16) + 8 * bj + 2 * wc + (fq >> 1)) * 512 + g * 16 + c0;
                    const u32x4 w4 = uv[m][bj]; f32x4 v0 = acc[ai][bj][m][0], v1 = acc[ai][bj][m][1];
                    v0[0] += d0[0] * bflo(w4[0]); v0[1] += d0[1] * bfhi(w4[0]); v0[2] += d0[2] * bflo(w4[1]); v0[3] += d0[3] * bfhi(w4[1]);
                    v1[0] += d1[0] * bflo(w4[2]); v1[1] += d1[1] * bfhi(w4[2]); v1[2] += d1[2] * bflo(w4[3]); v1[3] += d1[3] * bfhi(w4[3]);
#pragma unroll
                    for (int e = 0; e < 4; ++e) { v0[e] = gelu_tanh(v0[e]); v1[e] = gelu_tanh(v1[e]); }
                    *(u32x4*)p = pack8(v0, v1); }
            __builtin_amdgcn_sched_barrier(0); }
    }
};
struct EpiGLU {
    static constexpr bool PERM = true, MID = false; static constexpr int TMID = 0;
    int dummy;
    __device__ __forceinline__ void mid(Acc&, const Unit&, int, int, int, int) const {}
    __device__ __forceinline__ void operator()(const Acc& acc, const Unit& u, int wr, int wc, int fr, int fq) const {
        bf16_t* const VY = (bf16_t*)(wsp() + WS_VY);
        const int row0 = u.pm * 256 + wr * 64 + fr, c0 = u.pn * 128 + wc * 32 + 8 * fq;
#pragma unroll
        for (int ai = 0; ai < 2; ++ai)
#pragma unroll
            for (int m = 0; m < 4; ++m) { f32x4 v0, v1;
#pragma unroll
                for (int e = 0; e < 4; ++e) { v0[e] = acc[ai][0][m][0][e] * sigm(acc[ai][1][m][0][e]); v1[e] = acc[ai][0][m][1][e] * sigm(acc[ai][1][m][1][e]); }
                *(u32x4*)(VY + (size_t)(row0 + ai * 128 + m * 16) * 1536 + c0) = pack8(v0, v1); __builtin_amdgcn_sched_barrier(0); }
    }
};
struct EpiMerge {
    static constexpr bool PERM = true, MID = true; static constexpr int TMID = 8;
    int dummy;
    __device__ __forceinline__ void mid(Acc& acc, const Unit& u, int wr, int wc, int fr, int fq) const {
        const bf16_t* const R = (const bf16_t*)(wsp() + WS_R);
        const int row0 = u.pm * 256 + wr * 64 + fr, c0 = u.pn * 256 + wc * 32 + 8 * fq;
#pragma unroll
        for (int ai = 0; ai < 2; ++ai) {
            u32x4 rv[4][2];
#pragma unroll
            for (int m = 0; m < 4; ++m)
#pragma unroll
                for (int bj = 0; bj < 2; ++bj) rv[m][bj] = *(const u32x4*)(R + (size_t)(row0 + ai * 128 + m * 16) * 1024 + c0 + bj * 128);
            __builtin_amdgcn_sched_barrier(0);
#pragma unroll
            for (int m = 0; m < 4; ++m)
#pragma unroll
                for (int bj = 0; bj < 2; ++bj) { const u32x4 r4 = rv[m][bj];
                    acc[ai][bj][m][0][0] *= bflo(r4[0]); acc[ai][bj][m][0][1] *= bfhi(r4[0]); acc[ai][bj][m][0][2] *= bflo(r4[1]); acc[ai][bj][m][0][3] *= bfhi(r4[1]);
                    acc[ai][bj][m][1][0] *= bflo(r4[2]); acc[ai][bj][m][1][1] *= bfhi(r4[2]); acc[ai][bj][m][1][2] *= bflo(r4[3]); acc[ai][bj][m][1][3] *= bfhi(r4[3]); }
            __builtin_amdgcn_sched_barrier(0); }
    }
    __device__ __forceinline__ void operator()(const Acc& acc, const Unit& u, int wr, int wc, int fr, int fq) const {
        const bf16_t* const GG = (const bf16_t*)(wsp() + WS_GG); bf16_t* const MIX = (bf16_t*)(wsp() + WS_MIX);
        const int row0 = u.pm * 256 + wr * 64 + fr, c0 = u.pn * 256 + wc * 32 + 8 * fq;
#pragma unroll
        for (int ai = 0; ai < 2; ++ai) {
            u32x4 gq[4][2];
#pragma unroll
            for (int m = 0; m < 4; ++m)
#pragma unroll
                for (int bj = 0; bj < 2; ++bj) gq[m][bj] = *(const u32x4*)(GG + (size_t)(row0 + ai * 128 + m * 16) * 1024 + c0 + bj * 128);
            __builtin_amdgcn_sched_barrier(0);
#pragma unroll
            for (int m = 0; m < 4; ++m)
#pragma unroll
                for (int bj = 0; bj < 2; ++bj) { const size_t o = (size_t)(row0 + ai * 128 + m * 16) * 1024 + c0 + bj * 128; const u32x4 gv = gq[m][bj];
                    f32x4 v0 = acc[ai][bj][m][0], v1 = acc[ai][bj][m][1];
                    v0[0] *= bflo(gv[0]); v0[1] *= bfhi(gv[0]); v0[2] *= bflo(gv[1]); v0[3] *= bfhi(gv[1]);
                    v1[0] *= bflo(gv[2]); v1[1] *= bfhi(gv[2]); v1[2] *= bflo(gv[3]); v1[3] *= bfhi(gv[3]);
                    *(u32x4*)(MIX + o) = pack8(v0, v1); }
            __builtin_amdgcn_sched_barrier(0); }
    }
};
struct EpiRes {
    static constexpr bool PERM = false, MID = false; static constexpr int TMID = 0;
    int m0, fromx;
    __device__ __forceinline__ void mid(Acc&, const Unit&, int, int, int, int) const {}
    __device__ __forceinline__ void operator()(const Acc& acc, const Unit& u, int wr, int wc, int fr, int fq) const {
        float* const Hres = outp() + (size_t)m0 * 1024; const float* const Hsrc = (fromx ? inp(0) : (const float*)outp()) + (size_t)m0 * 1024;
        const int row0 = u.pm * 256 + wr * 64 + fr, c0 = u.pn * 256 + wc * 32 + 4 * fq;
#pragma unroll
        for (int ai = 0; ai < 2; ++ai)
#pragma unroll
            for (int mh = 0; mh < 2; ++mh) {
                f32x4 hv[2][2][2];
#pragma unroll
                for (int mm = 0; mm < 2; ++mm)
#pragma unroll
                    for (int bj = 0; bj < 2; ++bj)
#pragma unroll
                        for (int n = 0; n < 2; ++n) hv[mm][bj][n] = *(const f32x4*)(Hsrc + (size_t)(row0 + ai * 128 + (2 * mh + mm) * 16) * 1024 + c0 + bj * 128 + n * 16);
                __builtin_amdgcn_sched_barrier(0);
#pragma unroll
                for (int mm = 0; mm < 2; ++mm)
#pragma unroll
                    for (int bj = 0; bj < 2; ++bj)
#pragma unroll
                        for (int n = 0; n < 2; ++n) *(f32x4*)(Hres + (size_t)(row0 + ai * 128 + (2 * mh + mm) * 16) * 1024 + c0 + bj * 128 + n * 16) = hv[mm][bj][n] + acc[ai][bj][2 * mh + mm][n];
                __builtin_amdgcn_sched_barrier(0); }
    }
};
struct EpiGU {
    static constexpr bool PERM = true, MID = false; static constexpr int TMID = 0;
    int dummy;
    __device__ __forceinline__ void mid(Acc&, const Unit&, int, int, int, int) const {}
    __device__ __forceinline__ void operator()(const Acc& acc, const Unit& u, int wr, int wc, int fr, int fq) const {
        bf16_t* const H = (bf16_t*)(wsp() + WS_H);
        const int row0 = u.pm * 256 + wr * 64 + fr, c0 = u.pn * 128 + wc * 32 + 8 * fq;
#pragma unroll
        for (int ai = 0; ai < 2; ++ai)
#pragma unroll
            for (int m = 0; m < 4; ++m) { f32x4 v0, v1;
#pragma unroll
                for (int e = 0; e < 4; ++e) { v0[e] = silu_f(acc[ai][0][m][0][e]) * acc[ai][1][m][0][e]; v1[e] = silu_f(acc[ai][0][m][1][e]) * acc[ai][1][m][1][e]; }
                *(u32x4*)(H + (size_t)(row0 + ai * 128 + m * 16) * DFF + c0) = pack8(v0, v1); __builtin_amdgcn_sched_barrier(0); }
    }
};

__device__ __forceinline__ float shx(float v, int o, int lane) { return __builtin_bit_cast(float, __builtin_amdgcn_ds_bpermute((lane ^ o) << 2, __builtin_bit_cast(int, v))); }
__device__ __forceinline__ float wave_sum(float v, int lane) {
#pragma unroll
    for (int o = 32; o > 0; o >>= 1) v += shx(v, o, lane);
    return v;
}

template <bool FINAL>
__device__ __forceinline__ void norm_phase(const int WV, float* h, const float* g, bf16_t* xn, int r0, int r1, int blk, int nblk) {
    const int tid0 = ltid(), lane = tid0 & 63, wave = tid0 >> 6;
    f32x4 gv[4];
#pragma unroll
    for (int i = 0; i < 4; ++i) gv[i] = *(const f32x4*)(g + i * 256 + lane * 4);
    const int stride = nblk * 8;
    for (int row = (blk >= 0 ? r0 + blk * 8 + wave : r1); row < r1; row += 2 * stride) {
        const int row2 = row + stride; const bool has2 = row2 < r1;
        float* p = h + (size_t)row * 1024; float* p2 = h + (size_t)(has2 ? row2 : row) * 1024;
        f32x4 v[4], v2[4]; float ss = 0.f, ss2 = 0.f;
#pragma unroll
        for (int i = 0; i < 4; ++i) { v[i] = *(const f32x4*)(p + i * 256 + lane * 4); v2[i] = *(const f32x4*)(p2 + i * 256 + lane * 4); }
#pragma unroll
        for (int i = 0; i < 4; ++i) { ss += v[i][0] * v[i][0] + v[i][1] * v[i][1] + v[i][2] * v[i][2] + v[i][3] * v[i][3]; ss2 += v2[i][0] * v2[i][0] + v2[i][1] * v2[i][1] + v2[i][2] * v2[i][2] + v2[i][3] * v2[i][3]; }
        ss = wave_sum(ss, lane); ss2 = wave_sum(ss2, lane);
        const float rs = rsqrtf(ss * (1.0f / 1024.0f) + EPS), rs2 = rsqrtf(ss2 * (1.0f / 1024.0f) + EPS);
#pragma unroll
        for (int i = 0; i < 4; ++i) { f32x4 o;
#pragma unroll
            for (int e = 0; e < 4; ++e) o[e] = v[i][e] * rs * gv[i][e];
            if (FINAL) *(f32x4*)(p + i * 256 + lane * 4) = o;
            else { u32x2 w; w[0] = cvt_pk_bf16(o[0], o[1]); w[1] = cvt_pk_bf16(o[2], o[3]); *(u32x2*)(xn + (size_t)row * 1024 + i * 256 + lane * 4) = w; } }
        if (has2) {
#pragma unroll
            for (int i = 0; i < 4; ++i) { f32x4 o;
#pragma unroll
                for (int e = 0; e < 4; ++e) o[e] = v2[i][e] * rs2 * gv[i][e];
                if (FINAL) *(f32x4*)(p2 + i * 256 + lane * 4) = o;
                else { u32x2 w; w[0] = cvt_pk_bf16(o[0], o[1]); w[1] = cvt_pk_bf16(o[2], o[3]); *(u32x2*)(xn + (size_t)row2 * 1024 + i * 256 + lane * 4) = w; } }
        }
    }
}

__device__ __forceinline__ void xpose_tile(const int WV, LAS unsigned char* lds, const float* src, int lds_src, int col0, bf16_t* dst, int ldd, int row0, int k0, int dk0, float scale) {
    LAS float* T = (LAS float*)lds;
    const int tid = ltid();
    __syncthreads();
#pragma unroll
    for (int i = 0; i < 2; ++i) { const int r = (tid >> 4) + 32 * i, c4 = (tid & 15) * 4;
        const f32x4 v = *(const f32x4*)(src + (size_t)(k0 + r) * lds_src + col0 + c4);
        T[(c4 + 0) * 65 + r] = v[0]; T[(c4 + 1) * 65 + r] = v[1]; T[(c4 + 2) * 65 + r] = v[2]; T[(c4 + 3) * 65 + r] = v[3]; }
    __syncthreads();
    const int c = tid >> 3, kc = (tid & 7) * 8;
    u32x4 o;
#pragma unroll
    for (int e = 0; e < 4; ++e) o[e] = cvt_pk_bf16(T[c * 65 + kc + 2 * e] * scale, T[c * 65 + kc + 2 * e + 1] * scale);
    *(u32x4*)(dst + (size_t)(row0 + c) * ldd + dk0 + k0 + kc) = o;
}

__device__ __forceinline__ void xpose_item(int lane, LAS float* scr, const float* src, int ld_src, int col0, bf16_t* dst, int ldd, int row0, int k0, int dk0, float scale) {
#pragma unroll 8
    for (int i = 0; i < 32; ++i) { const int kk = 2 * i + (lane >> 5); scr[kk * 33 + (lane & 31)] = src[(size_t)(k0 + kk) * ld_src + col0 + (lane & 31)] * scale; }
    asm volatile("s_waitcnt lgkmcnt(0)" ::: "memory");
    const int c = lane & 7;
#pragma unroll
    for (int j = 0; j < 4; ++j) { const int n = (lane >> 3) + 8 * j; const LAS float* t = scr + (8 * c) * 33 + n;
        u32x4 o; o[0] = cvt_pk_bf16(t[0 * 33], t[1 * 33]); o[1] = cvt_pk_bf16(t[2 * 33], t[3 * 33]); o[2] = cvt_pk_bf16(t[4 * 33], t[5 * 33]); o[3] = cvt_pk_bf16(t[6 * 33], t[7 * 33]);
        *(u32x4*)(dst + (size_t)(row0 + n) * ldd + dk0 + k0 + 8 * c) = o; }
    asm volatile("s_waitcnt lgkmcnt(0)" ::: "memory");
}
__device__ __forceinline__ void prep_phase(const int WV, int L, LAS unsigned char* lds) {
    unsigned char* ws = wsp();
    bf16_t* WIN = (bf16_t*)(ws + WS_WIN); bf16_t* WGLU = (bf16_t*)(ws + WS_WGLU); bf16_t* WMRG = (bf16_t*)(ws + WS_WMRG); bf16_t* WOUT = (bf16_t*)(ws + WS_WOUT);
    bf16_t* WGU = (bf16_t*)(ws + WS_WGU); bf16_t* WDN = (bf16_t*)(ws + WS_WDN); bf16_t* BTY = (bf16_t*)(ws + WS_BTY); bf16_t* BTZ = (bf16_t*)(ws + WS_BTZ); float* LAM = (float*)(ws + WS_LAM);
    const float* w_in = inp(2) + (size_t)L * DM * DIN;
    const float* w_glu = inp(11) + (size_t)L * 512 * 1024;
    const float* w_bs5 = inp(15) + (size_t)L * 512 * 1024;
    const float* w_bgla = inp(16) + (size_t)L * 1024 * 1024;
    const float* w_out = inp(17) + (size_t)L * 1024 * 1024;
    const float* w_fg = inp(19) + (size_t)L * DM * DFF;
    const float* w_fu = inp(20) + (size_t)L * DM * DFF;
    const float* w_fd = inp(21) + (size_t)L * DFF * DM;
    const float* w_gup = inp(12) + (size_t)L * 16 * 512;
    constexpr int J_WIN = 176 * 16, J_GLU = 32 * 8, J_M1 = 32 * 8, J_M2 = 32 * 16, J_OUT = 32 * 16, J_GU = 176 * 16, J_DN = 32 * 44;
    constexpr int J_TOT = J_WIN + J_GLU + J_M1 + J_M2 + J_OUT + J_GU + J_DN;
    const int nS5 = (gridDim.x >= 64) ? 32 : 0;
    const int wblk = (int)blockIdx.x - nS5, nwblk = (int)gridDim.x - nS5;
    {
        const int tidx = ltid(), xlane = tidx & 63, xwave = tidx >> 6;
        LAS float* scr = (LAS float*)(lds + xwave * 8448);
        for (int job = wblk * 8 + xwave; wblk >= 0 && job < J_TOT; job += nwblk * 8) {
            int j = job;
            if (j < J_WIN) { const int nt = j >> 4, kt = j & 15, n0 = nt * 32; int col0; float sc = 1.f;
                if (n0 < 3584) { col0 = n0; if (n0 >= 512 && n0 < 1024) sc = 0.08838834764831845f; }
                else { const int T = (n0 - 3584) >> 8, jj = (n0 - 3584) & 255; col0 = (jj < 128) ? (3600 + 128 * T + jj) : (4624 + 128 * T + jj - 128); }
                xpose_item(xlane, scr, w_in, DIN, col0, WIN, 1024, n0, kt * 64, 0, sc); continue; }
            j -= J_WIN;
            if (j < J_GLU) { const int nt = j >> 3, kt = j & 7, n0 = nt * 32, T = n0 >> 8, jj = n0 & 255; const int col0 = (jj < 128) ? (128 * T + jj) : (512 + 128 * T + jj - 128);
                xpose_item(xlane, scr, w_glu, 1024, col0, WGLU, 512, n0, kt * 64, 0, 1.f); continue; }
            j -= J_GLU;
            if (j < J_M1) { const int nt = j >> 3, kt = j & 7; xpose_item(xlane, scr, w_bs5, 1024, nt * 32, WMRG, 1536, nt * 32, kt * 64, 0, 1.f); continue; }
            j -= J_M1;
            if (j < J_M2) { const int nt = j >> 4, kt = j & 15; xpose_item(xlane, scr, w_bgla, 1024, nt * 32, WMRG, 1536, nt * 32, kt * 64, 512, 1.f); continue; }
            j -= J_M2;
            if (j < J_OUT) { const int nt = j >> 4, kt = j & 15; xpose_item(xlane, scr, w_out, 1024, nt * 32, WOUT, 1024, nt * 32, kt * 64, 0, 1.f); continue; }
            j -= J_OUT;
            if (j < J_GU) { const int nt = j >> 4, kt = j & 15, n0 = nt * 32, T = n0 >> 8, jj = n0 & 255;
                if (jj < 128) xpose_item(xlane, scr, w_fg, DFF, 128 * T + jj, WGU, 1024, n0, kt * 64, 0, 1.f);
                else xpose_item(xlane, scr, w_fu, DFF, 128 * T + jj - 128, WGU, 1024, n0, kt * 64, 0, 1.f);
                continue; }
            j -= J_GU;
            { const int nt = j / 44, kt = j % 44; xpose_item(xlane, scr, w_fd, 1024, nt * 32, WDN, DFF, nt * 32, kt * 64, 0, 1.f); }
        }
    }
    {
        bf16_t* WALOW = (bf16_t*)(ws + WS_WALOW); u32x2* WG2 = (u32x2*)(ws + WS_WG2);
        const int e = wblk * NTHR + ltid();
        if (wblk >= 0 && e < 16 * 1024) { const int r = e >> 10, k = e & 1023; WALOW[r * 1024 + k] = f2bf(w_in[(size_t)k * DIN + 3584 + r]); }
        if (wblk >= 0 && e < 32 * 64) { const int nt = e >> 6, l = e & 63, cfr = l & 15, cfq = l >> 4; const float* wg = w_gup + (4 * cfq) * 512 + nt * 16 + cfr;
            u32x2 t; t[0] = (unsigned)f2bf(wg[0]) | ((unsigned)f2bf(wg[512]) << 16); t[1] = (unsigned)f2bf(wg[1024]) | ((unsigned)f2bf(wg[1536]) << 16); WG2[e] = t; }
    }
    __syncthreads();
    LAS float* PW = (LAS float*)lds;
    LAS float* BB = PW + 17 * 64 * 2;
    LAS float* CC = BB + 64 * 16 * 2;
    LAS float* KJ = CC + 16 * 64 * 2;
    const int tid = ltid();
    for (int g = blockIdx.x; g < 32 && (nS5 == 0 || (int)blockIdx.x < nS5); g += (nS5 ? nS5 : (int)gridDim.x)) {
        __syncthreads();
        const float dt = __expf(inp(5)[L * 32 + g]);
        if (tid < 64) { const int p = tid; const float ar = inp(3)[(L * 32 + g) * 64 + p], ai = inp(4)[(L * 32 + g) * 64 + p]; const float zr = ar * dt, zi = ai * dt;
            for (int j = 0; j <= 16; ++j) { const float mag = __expf((float)j * zr), ang = (float)j * zi; PW[(j * 64 + p) * 2] = mag * __cosf(ang); PW[(j * 64 + p) * 2 + 1] = mag * __sinf(ang); }
            const float xr = PW[(64 + p) * 2] - 1.0f, xi = PW[(64 + p) * 2 + 1], den = 1.0f / (ar * ar + ai * ai);
            const float cr = (xr * ar + xi * ai) * den, ci = (xi * ar - xr * ai) * den;
            LAM[(g * 64 + p) * 2] = PW[(16 * 64 + p) * 2]; LAM[(g * 64 + p) * 2 + 1] = PW[(16 * 64 + p) * 2 + 1];
            for (int c = 0; c < 16; ++c) { const float br = inp(6)[((size_t)(L * 32 + g) * 64 + p) * 16 + c], bi = inp(7)[((size_t)(L * 32 + g) * 64 + p) * 16 + c];
                BB[(p * 16 + c) * 2] = cr * br - ci * bi; BB[(p * 16 + c) * 2 + 1] = cr * bi + ci * br; } }
        for (int e = tid; e < 1024; e += NTHR) { CC[e * 2] = inp(8)[(size_t)(L * 32 + g) * 1024 + e]; CC[e * 2 + 1] = inp(9)[(size_t)(L * 32 + g) * 1024 + e]; }
        __syncthreads();
        for (int e = tid; e < 4096; e += NTHR) { const int j = e >> 8, c = (e >> 4) & 15, c2 = e & 15; float s = 0.f;
            for (int p = 0; p < 64; ++p) { const float cr = CC[(c * 64 + p) * 2], ci = CC[(c * 64 + p) * 2 + 1], pr = PW[(j * 64 + p) * 2], pi = PW[(j * 64 + p) * 2 + 1];
                const float tr = cr * pr - ci * pi, ti = cr * pi + ci * pr; s += tr * BB[(p * 16 + c2) * 2] - ti * BB[(p * 16 + c2) * 2 + 1]; }
            KJ[e] = s; }
        __syncthreads();
        for (int e = tid; e < 256 * 384; e += NTHR) { const int n = e / 384, k = e % 384, t = n >> 4, c = n & 15; float v;
            if (k < 256) { const int tau = k >> 4, c2 = k & 15; v = (tau <= t) ? KJ[((t - tau) * 16 + c) * 16 + c2] : 0.f; }
            else { const int q = k - 256, p = q & 63; const float cr = CC[(c * 64 + p) * 2], ci = CC[(c * 64 + p) * 2 + 1], pr = PW[((t + 1) * 64 + p) * 2], pi = PW[((t + 1) * 64 + p) * 2 + 1];
                v = (q < 64) ? (cr * pr - ci * pi) : -(cr * pi + ci * pr); }
            BTY[(size_t)g * 256 * 384 + e] = f2bf(v); }
        for (int e = tid; e < 256 * 256; e += NTHR) { const int n = e >> 8, k = e & 255, tau = k >> 4, c2 = k & 15; float v = 0.f;
            if (n < 128) { const int p = n & 63; const float pr = PW[((15 - tau) * 64 + p) * 2], pi = PW[((15 - tau) * 64 + p) * 2 + 1], br = BB[(p * 16 + c2) * 2], bi = BB[(p * 16 + c2) * 2 + 1];
                v = (n < 64) ? (pr * br - pi * bi) : (pr * bi + pi * br); }
            BTZ[(size_t)g * 65536 + e] = f2bf(v); }
    }
    __syncthreads();
}

__device__ __forceinline__ void s5_scan_phase(const int WV, LAS unsigned char* lds) {
    const float* Z = (const float*)(wsp() + WS_Z); const float* LAM = (const float*)(wsp() + WS_LAM); bf16_t* SU = (bf16_t*)(wsp() + WS_SU);
    LAS float* SEG = (LAS float*)lds;
    const int tid = ltid(), p = tid & 63, seg = tid >> 6;
    for (int unit = blockIdx.x; unit < 256; unit += gridDim.x) {
        const int b = unit >> 5, g = unit & 31;
        const float lr = LAM[(g * 64 + p) * 2], li = LAM[(g * 64 + p) * 2 + 1];
        const int j0 = b * 256 + seg * 32;
        float zr[32], zi[32];
#pragma unroll
        for (int s = 0; s < 32; ++s) { const float* zp = Z + ((size_t)(j0 + s) * 32 + g) * 128; zr[s] = zp[p]; zi[s] = zp[64 + p]; }
        float er = 0.f, ei = 0.f;
#pragma unroll
        for (int s = 0; s < 32; ++s) { const float nr = lr * er - li * ei + zr[s], ni = lr * ei + li * er + zi[s]; er = nr; ei = ni; }
        __syncthreads();
        SEG[(seg * 64 + p) * 2] = er; SEG[(seg * 64 + p) * 2 + 1] = ei;
        __syncthreads();
        float l32r = lr, l32i = li;
#pragma unroll
        for (int q = 0; q < 5; ++q) { const float nr = l32r * l32r - l32i * l32i, ni = 2.f * l32r * l32i; l32r = nr; l32i = ni; }
        float cr = 0.f, ci = 0.f;
        for (int s2 = 0; s2 < seg; ++s2) { const float sr = SEG[(s2 * 64 + p) * 2], si = SEG[(s2 * 64 + p) * 2 + 1]; const float nr = l32r * cr - l32i * ci + sr, ni = l32r * ci + l32i * cr + si; cr = nr; ci = ni; }
#pragma unroll
        for (int s = 0; s < 32; ++s) { const int j = j0 + s;
            SU[(size_t)(16 * j + (p >> 4)) * 512 + g * 16 + (p & 15)] = f2bf(cr);
            SU[(size_t)(16 * j + 4 + (p >> 4)) * 512 + g * 16 + (p & 15)] = f2bf(ci);
            const float nr = lr * cr - li * ci + zr[s], ni = lr * ci + li * cr + zi[s]; cr = nr; ci = ni; }
    }
}

__device__ __forceinline__ void la_phase(const int WV, int L) {
    unsigned char* ws = wsp();
    const bf16_t* XNp = (const bf16_t*)(ws + WS_XN); const bf16_t* WALOW = (const bf16_t*)(ws + WS_WALOW); const u32x2* WG2 = (const u32x2*)(ws + WS_WG2);
    const float* bgate = inp(13) + L * 512; unsigned short* LAo = (unsigned short*)(ws + WS_LA);
    const int tid = ltid(), lane = tid & 63, wave = tid >> 6, fr = lane & 15, fq = lane >> 4;
    for (int tile = blockIdx.x * 8 + wave; tile < MTOK / 16; tile += gridDim.x * 8) {
        const int tok0 = tile * 16;
        float zf; asm volatile("v_mov_b32 %0, 0" : "=v"(zf));
        f32x4 acc = (f32x4){zf, zf, zf, zf};
        const bf16_t* ap = WALOW + (size_t)fr * 1024 + 8 * fq; const bf16_t* bp = XNp + (size_t)(tok0 + fr) * 1024 + 8 * fq;
#pragma unroll 8
        for (int ks = 0; ks < 32; ++ks) { const bf16x8 aW = *(const bf16x8*)(ap + 32 * ks), bX = *(const bf16x8*)(bp + 32 * ks);
            acc = __builtin_amdgcn_mfma_f32_16x16x32_bf16(aW, bX, acc, 0, 0, 0); }
        MFMA_SETTLE();
        const u32x4 a2 = (u32x4){cvt_pk_bf16(acc[0], acc[1]), cvt_pk_bf16(acc[2], acc[3]), 0u, 0u};
        const bf16x8 A2 = __builtin_bit_cast(bf16x8, a2);
        unsigned short* lrow = LAo + (size_t)(tok0 + fr) * 512 + 4 * fq;
#pragma unroll 4
        for (int nt = 0; nt < 32; ++nt) { const u32x2 w2 = WG2[nt * 64 + lane]; const u32x4 b4 = (u32x4){w2[0], w2[1], 0u, 0u};
            const f32x4 d = __builtin_amdgcn_mfma_f32_16x16x32_bf16(__builtin_bit_cast(bf16x8, b4), A2, (f32x4){zf, zf, zf, zf}, 0, 0, 0);
            const f32x4 bb = *(const f32x4*)(bgate + nt * 16 + 4 * fq);
            u32x2 o; o[0] = pk_h2(logsig(d[0] + bb[0]) * 0.0625f, logsig(d[1] + bb[1]) * 0.0625f); o[1] = pk_h2(logsig(d[2] + bb[2]) * 0.0625f, logsig(d[3] + bb[3]) * 0.0625f);
            *(u32x2*)(lrow + nt * 16) = o; }
    }
}
constexpr int GL_KT = 0, GL_VT = 18432, GL_QS = 55296, GL_DEC = 72704, GL_PART = 73216, GL_RED = 75264;
template <bool WITH_O>
__device__ __forceinline__ void gla_phase(const int WV, int L, LAS unsigned char* lds) {
    unsigned char* ws = wsp();
    const bf16_t* Q = (const bf16_t*)(ws + WS_Q); const bf16_t* KB = (const bf16_t*)(ws + WS_KB); const unsigned short* LA = (const unsigned short*)(ws + WS_LA);
    bf16_t* VY = (bf16_t*)(ws + WS_VY); const bf16_t* SG = (const bf16_t*)(ws + WS_SG); u32x2* KV = (u32x2*)(ws + WS_KV); float* DEC = (float*)(ws + WS_DEC); float* DECC = (float*)(ws + WS_DECC);
    const float* ng = inp(14) + (size_t)L * 1024;
    const int tid = ltid(), lane = tid & 63, w = tid >> 6, fr = lane & 15, fq = lane >> 4;
    const int kk = tid & 127, tq = tid >> 7;
    LAS float* DECS = (LAS float*)(lds + GL_DEC); LAS float* PART = (LAS float*)(lds + GL_PART); LAS float* RED = (LAS float*)(lds + GL_RED);
    for (int unit = blockIdx.x; unit < 512; unit += gridDim.x) {
        const int h = unit & 3, sc = (unit >> 2) & 15, b = unit >> 6;
        const int t0 = b * 4096 + sc * 256;
        float zf; asm volatile("v_mov_b32 %0, 0" : "=v"(zf));
        f32x4 S[8][2];
#pragma unroll
        for (int mt = 0; mt < 8; ++mt)
#pragma unroll
            for (int nt = 0; nt < 2; ++nt) { if (WITH_O) { const u32x2 kw = KV[((size_t)unit * 16 + mt * 2 + nt) * 512 + tid]; S[mt][nt] = (f32x4){bflo(kw[0]), bfhi(kw[0]), bflo(kw[1]), bfhi(kw[1])}; } else S[mt][nt] = (f32x4){zf, zf, zf, zf}; }
        float dprod = 1.0f;
        unsigned short la_r[16], k_r[16]; u32x4 v_r[4]; u32x4 q_r[2]; u32x4 kt_r[2]; float dec_r = 0.f;
#define GLA_LOAD(tok0_) do { \
            if (!WITH_O) { _Pragma("unroll") for (int i = 0; i < 16; ++i) { const size_t o = (size_t)((tok0_) + 16 * tq + i) * 512 + h * 128 + kk; la_r[i] = LA[o]; k_r[i] = KB[o]; } } \
            else { _Pragma("unroll") for (int i = 0; i < 2; ++i) { const int pc = tid + 512 * i, k2 = pc >> 3, j = pc & 7; kt_r[i] = *(const u32x4*)((const unsigned char*)LA + (size_t)((tok0_) + (k2 >> 1)) * 1024 + h * 256 + (k2 & 1) * 128 + j * 16); } \
                   dec_r = DECC[(size_t)(unit * 4 + (((tok0_) - t0) >> 6)) * 128 + kk]; } \
            _Pragma("unroll") for (int i = 0; i < 4; ++i) { const int pc = tid + 512 * i, token = pc >> 5, vc = (pc & 31) * 8; v_r[i] = *(const u32x4*)(VY + (size_t)((tok0_) + token) * 1536 + 512 + h * 256 + vc); } \
            if (WITH_O) { _Pragma("unroll") for (int i = 0; i < 2; ++i) { const int pc = tid + 512 * i, token = pc >> 4, kc = (pc & 15) * 8; q_r[i] = *(const u32x4*)(Q + (size_t)((tok0_) + token) * 512 + h * 128 + kc); } } \
        } while (0)
        GLA_LOAD(t0);
        for (int c = 0; c < 4; ++c) {
            const int tok0 = t0 + 64 * c;
            if (!WITH_O) {
            float lav[16], kf[16]; float ps = 0.f;
#pragma unroll
            for (int i = 0; i < 16; ++i) { lav[i] = h2f(la_r[i]); kf[i] = bf2f(k_r[i]); ps += lav[i]; }
            __syncthreads();
            PART[tq * 128 + kk] = ps;
#pragma unroll
            for (int i = 0; i < 4; ++i) { const int pc = tid + 512 * i, token = pc >> 5, vc = (pc & 31) * 8; *(LAS u32x4*)(lds + GL_VT + token * 544 + vc * 2) = v_r[i]; }
            if (WITH_O) {
#pragma unroll
                for (int i = 0; i < 2; ++i) { const int pc = tid + 512 * i, token = pc >> 4, kc = (pc & 15) * 8; *(LAS u32x4*)(lds + GL_QS + token * 272 + kc * 2) = q_r[i]; } }
            __syncthreads();
            {
                float off = 0.f, tot = 0.f;
#pragma unroll
                for (int q = 0; q < 4; ++q) { const float pv = PART[q * 128 + kk]; tot += pv; if (q < tq) off += pv; }
                float run = off; unsigned pk[8];
#pragma unroll
                for (int i = 0; i < 16; i += 2) { run += lav[i]; const float e0 = kf[i] * __expf(tot - run); run += lav[i + 1]; const float e1 = kf[i + 1] * __expf(tot - run); pk[i >> 1] = cvt_pk_bf16(e0, e1); }
                LAS u32x4* kd = (LAS u32x4*)(lds + GL_KT + kk * 144 + tq * 32);
                kd[0] = (u32x4){pk[0], pk[1], pk[2], pk[3]}; kd[1] = (u32x4){pk[4], pk[5], pk[6], pk[7]};
                if (!WITH_O) {
                    u32x4* ke = (u32x4*)((unsigned char*)LA + (size_t)(tok0 + (kk >> 1)) * 1024 + h * 256 + (kk & 1) * 128 + tq * 32);
                    ke[0] = (u32x4){pk[0], pk[1], pk[2], pk[3]}; ke[1] = (u32x4){pk[4], pk[5], pk[6], pk[7]}; }
                if (tq == 0) { const float d = __expf(tot); DECS[kk] = d; dprod *= d; if (!WITH_O) DECC[(size_t)(unit * 4 + c) * 128 + kk] = d; }
            }
            } else {
            __syncthreads();
#pragma unroll
            for (int i = 0; i < 4; ++i) { const int pc = tid + 512 * i, token = pc >> 5, vc = (pc & 31) * 8; *(LAS u32x4*)(lds + GL_VT + token * 544 + vc * 2) = v_r[i]; }
#pragma unroll
            for (int i = 0; i < 2; ++i) { const int pc = tid + 512 * i, token = pc >> 4, kc = (pc & 15) * 8; *(LAS u32x4*)(lds + GL_QS + token * 272 + kc * 2) = q_r[i]; }
#pragma unroll
            for (int i = 0; i < 2; ++i) { const int pc = tid + 512 * i, k2 = pc >> 3, j = pc & 7; *(LAS u32x4*)(lds + GL_KT + k2 * 144 + j * 16) = kt_r[i]; }
            if (tq == 0) DECS[kk] = dec_r;
            }
            if (c < 3) GLA_LOAD(tok0 + 64);
            u32x2 sgv[4][2];
            if (WITH_O) {
#pragma unroll
                for (int tt = 0; tt < 4; ++tt)
#pragma unroll
                    for (int nt = 0; nt < 2; ++nt) sgv[tt][nt] = *(const u32x2*)(SG + (size_t)(tok0 + 16 * tt + fr) * 1024 + h * 256 + 32 * w + 16 * nt + 4 * fq); }
            __syncthreads();
#pragma unroll
            for (int mt = 0; mt < 8; ++mt) { const f32x4 dv = *(const LAS f32x4*)(DECS + 16 * mt + 4 * fq);
#pragma unroll
                for (int nt = 0; nt < 2; ++nt) S[mt][nt] = S[mt][nt] * dv; }
#pragma unroll
            for (int ks = 0; ks < 2; ++ks) { bf16x8 bV[2];
                {
                    const unsigned vaddr = (unsigned)(__SIZE_TYPE__)(lds + GL_VT) + (unsigned)((32 * ks + 8 * fq + ((lane & 15) >> 2)) * 544 + 64 * w + 8 * (lane & 3));
                    u32x2 t00, t01, t10, t11;
                    asm volatile("ds_read_b64_tr_b16 %0, %4 offset:0\n\tds_read_b64_tr_b16 %1, %4 offset:2176\n\tds_read_b64_tr_b16 %2, %4 offset:32\n\tds_read_b64_tr_b16 %3, %4 offset:2208\n\ts_waitcnt lgkmcnt(0)"
                                 : "=&v"(t00), "=&v"(t01), "=&v"(t10), "=&v"(t11) : "v"(vaddr) : "memory");
                    __builtin_amdgcn_sched_barrier(0);
                    const u32x4 b0 = (u32x4){t00[0], t00[1], t01[0], t01[1]}, b1 = (u32x4){t10[0], t10[1], t11[0], t11[1]};
                    bV[0] = __builtin_bit_cast(bf16x8, b0); bV[1] = __builtin_bit_cast(bf16x8, b1);
                }
#pragma unroll
                for (int mt = 0; mt < 8; ++mt) { const bf16x8 aK = *(const LAS bf16x8*)(lds + GL_KT + (16 * mt + fr) * 144 + ks * 64 + fq * 16);
#pragma unroll
                    for (int nt = 0; nt < 2; ++nt) S[mt][nt] = __builtin_amdgcn_mfma_f32_16x16x32_bf16(aK, bV[nt], S[mt][nt], 0, 0, 0); } }
            MFMA_SETTLE();
            if (WITH_O) {
                f32x4 O[2][4];
#pragma unroll
                for (int nt = 0; nt < 2; ++nt)
#pragma unroll
                    for (int tt = 0; tt < 4; ++tt) O[nt][tt] = (f32x4){zf, zf, zf, zf};
#pragma unroll
                for (int ks = 0; ks < 4; ++ks) { bf16x8 aS[2];
#pragma unroll
                    for (int nt = 0; nt < 2; ++nt) { const u32x4 pkd = pack8(S[2 * ks][nt], S[2 * ks + 1][nt]); aS[nt] = __builtin_bit_cast(bf16x8, pkd); }
#pragma unroll
                    for (int tt = 0; tt < 4; ++tt) { const LAS unsigned char* qp = lds + GL_QS + (16 * tt + fr) * 272 + (32 * ks + 4 * fq) * 2;
                        const u32x2 q0 = *(const LAS u32x2*)qp, q1 = *(const LAS u32x2*)(qp + 32);
                        const u32x4 qq = (u32x4){q0[0], q0[1], q1[0], q1[1]}; const bf16x8 bQ = __builtin_bit_cast(bf16x8, qq);
#pragma unroll
                        for (int nt = 0; nt < 2; ++nt) O[nt][tt] = __builtin_amdgcn_mfma_f32_16x16x32_bf16(aS[nt], bQ, O[nt][tt], 0, 0, 0); } }
                float ss[4];
#pragma unroll
                for (int tt = 0; tt < 4; ++tt) { float s = 0.f;
#pragma unroll
                    for (int nt = 0; nt < 2; ++nt)
#pragma unroll
                        for (int e = 0; e < 4; ++e) s += O[nt][tt][e] * O[nt][tt][e];
                    s += shx(s, 16, lane); s += shx(s, 32, lane); ss[tt] = s; }
                if (fq == 0) {
#pragma unroll
                    for (int tt = 0; tt < 4; ++tt) RED[w * 64 + 16 * tt + fr] = ss[tt]; }
                __syncthreads();
#pragma unroll
                for (int tt = 0; tt < 4; ++tt) { float s = 0.f;
#pragma unroll
                    for (int w2 = 0; w2 < 8; ++w2) s += RED[w2 * 64 + 16 * tt + fr];
                    const float rs = rsqrtf(s * (1.0f / 256.0f) + EPS);
#pragma unroll
                    for (int nt = 0; nt < 2; ++nt) { const int vcol = h * 256 + 32 * w + 16 * nt + 4 * fq; const size_t tok = (size_t)(tok0 + 16 * tt + fr);
                        const f32x4 gv = *(const f32x4*)(ng + vcol); const u32x2 sg = sgv[tt][nt];
                        const float y0 = O[nt][tt][0] * rs * gv[0] * bflo(sg[0]), y1 = O[nt][tt][1] * rs * gv[1] * bfhi(sg[0]);
                        const float y2 = O[nt][tt][2] * rs * gv[2] * bflo(sg[1]), y3 = O[nt][tt][3] * rs * gv[3] * bfhi(sg[1]);
                        u32x2 o; o[0] = cvt_pk_bf16(y0, y1); o[1] = cvt_pk_bf16(y2, y3);
                        *(u32x2*)(VY + tok * 1536 + 512 + vcol) = o; } }
            }
        }
#undef GLA_LOAD
        if (!WITH_O) {
#pragma unroll
            for (int mt = 0; mt < 8; ++mt)
#pragma unroll
                for (int nt = 0; nt < 2; ++nt) { u32x2 kw; kw[0] = cvt_pk_bf16(S[mt][nt][0], S[mt][nt][1]); kw[1] = cvt_pk_bf16(S[mt][nt][2], S[mt][nt][3]); KV[((size_t)unit * 16 + mt * 2 + nt) * 512 + tid] = kw; }
            if (tid < 128) DEC[unit * 128 + tid] = dprod;
        }
    }
    __syncthreads();
}
__device__ __forceinline__ void gla_scan_phase(const int WV) {
    u32x2* KV = (u32x2*)(wsp() + WS_KV); const float* DEC = (const float*)(wsp() + WS_DEC);
    for (int item = blockIdx.x * NTHR + ltid(); item < 262144; item += gridDim.x * NTHR) {
        const int tid2 = item & 511, r = (item >> 9) & 15, bh = item >> 13, b = bh >> 2, h = bh & 3;
        const int mt = r >> 1, fq = (tid2 & 63) >> 4;
        u32x2 kv[16];
#pragma unroll
        for (int sc = 0; sc < 16; ++sc) { const int unit = (b * 16 + sc) * 4 + h; kv[sc] = KV[((size_t)unit * 16 + r) * 512 + tid2]; }
        float zf; asm volatile("v_mov_b32 %0, 0" : "=v"(zf));
        f32x4 S = (f32x4){zf, zf, zf, zf};
#pragma unroll
        for (int sc = 0; sc < 16; ++sc) { const int unit = (b * 16 + sc) * 4 + h;
            u32x2 o; o[0] = cvt_pk_bf16(S[0], S[1]); o[1] = cvt_pk_bf16(S[2], S[3]);
            KV[((size_t)unit * 16 + r) * 512 + tid2] = o;
            const f32x4 d = *(const f32x4*)(DEC + unit * 128 + 16 * mt + 4 * fq);
            const f32x4 kvf = (f32x4){bflo(kv[sc][0]), bfhi(kv[sc][0]), bflo(kv[sc][1]), bfhi(kv[sc][1])};
            S = S * d + kvf; }
    }
}
#define XB_TMO      128
#define XB_XCNT(j)  (256  + 64 * (j))
#define XB_XSUB(j)  (1280 + 64 * (j))
#define XB_XGEN(j)  (2304 + 64 * (j))
#define XB_TOP      3328
#define XB_TOPGEN   3392
#define XCD_BAR_WORDS 3456
#define XB_SPIN_CAP (1u << 24)
constexpr int XB_LDS_OFF = 131072 + 64;
__device__ __forceinline__ unsigned xb_ld(unsigned* p)              { return __hip_atomic_load(p, __ATOMIC_RELAXED, __HIP_MEMORY_SCOPE_AGENT); }
__device__ __forceinline__ unsigned xb_add(unsigned* p, unsigned v) { return __hip_atomic_fetch_add(p, v, __ATOMIC_RELAXED, __HIP_MEMORY_SCOPE_AGENT); }
__device__ __forceinline__ unsigned xb_xcc_id() { return (unsigned)__builtin_amdgcn_s_getreg((3 << 11) | 20) & 0xFu; }
#define XB_SPIN(cond, bar) do { unsigned _sp = 0; while (cond) { __builtin_amdgcn_s_sleep(1); \
    if ((++_sp & 255u) == 0u) { if (xb_ld(&(bar)[XB_TMO])) break; if (_sp > XB_SPIN_CAP) { atomicAdd(&(bar)[XB_TMO], 1u); break; } } } } while (0)
__device__ __forceinline__ void xcd_barrier_complete(unsigned* bar, unsigned x, unsigned G, unsigned& nloc, unsigned& nx) {
    unsigned sum, cnt, mine, sp = 0u;
    for (;;) {
        sum = 0u; cnt = 0u; mine = 0u;
#pragma unroll
        for (unsigned j = 0; j < 16; ++j) { const unsigned c = xb_ld(&bar[XB_XCNT(j)]); sum += c; cnt += (c > 0u) ? 1u : 0u; mine = (j == x) ? c : mine; }
        if (sum == G) break;
        __builtin_amdgcn_s_sleep(1);
        if ((++sp & 255u) == 0u) { if (xb_ld(&bar[XB_TMO])) break; if (sp > XB_SPIN_CAP) { atomicAdd(&bar[XB_TMO], 1u); break; } }
    }
    nloc = mine > 0u ? mine : 1u; nx = cnt > 0u ? cnt : 1u;
}
__device__ __forceinline__ void grid_barrier(const int WV, LAS unsigned char* lds, const int G) {
    asm volatile("s_waitcnt vmcnt(0)" ::: "memory");
    __syncthreads();
    unsigned* const bar = (unsigned*)wsp();
    if (ltid() == 0) {
        volatile LAS unsigned* st = (volatile LAS unsigned*)(lds + XB_LDS_OFF);
        const unsigned x = xb_xcc_id();
        __builtin_amdgcn_s_waitcnt(0);
        unsigned nloc = st[0], nx = st[1];
        if (nloc == 0u) { xcd_barrier_complete(bar, x, (unsigned)G, nloc, nx); st[0] = nloc; st[1] = nx; }
        const unsigned old = xb_add(&bar[XB_XSUB(x)], 1u);
        const unsigned gen = old / nloc;
        if (old + 1u == (gen + 1u) * nloc) {
            __builtin_amdgcn_fence(__ATOMIC_RELEASE, "agent");
            asm volatile("s_waitcnt vmcnt(0)" ::: "memory");
            const unsigned og = xb_add(&bar[XB_TOP], 1u);
            const unsigned tg = og / nx;
            if (og + 1u == (tg + 1u) * nx) xb_add(&bar[XB_TOPGEN], 1u);
            else XB_SPIN(xb_ld(&bar[XB_TOPGEN]) == tg, bar);
            __builtin_amdgcn_fence(__ATOMIC_ACQUIRE, "agent");
            xb_add(&bar[XB_XGEN(x)], 1u);
            asm volatile("s_waitcnt vmcnt(0)" ::: "memory");
        } else {
            XB_SPIN(xb_ld(&bar[XB_XGEN(x)]) == gen, bar);
            __builtin_amdgcn_fence(__ATOMIC_ACQUIRE, "agent");
            asm volatile("s_waitcnt vmcnt(0)" ::: "memory");
        }
    }
    __syncthreads();
}
#ifdef PROBE_BAR
#define GSYNC() do { grid_barrier(WV, lds, G); grid_barrier(WV, lds, G); } while (0)
#else
#define GSYNC() grid_barrier(WV, lds, G)
#endif

__global__ void __launch_bounds__(NTHR, 2) fwd_megakernel(Args a_unused) {
    extern __shared__ __attribute__((aligned(16))) unsigned char lds_raw[];
    LAS unsigned char* lds = (LAS unsigned char*)lds_raw;
    cg::this_grid().sync();
    int WV = __builtin_amdgcn_readfirstlane(threadIdx.x >> 6); asm volatile("" : "+s"(WV));
    const int G = gridDim.x, bid = blockIdx.x;
#define ws wsp()
    { unsigned* const bar0 = (unsigned*)wsp(); if (ltid() == 0) { volatile LAS unsigned* st = (volatile LAS unsigned*)(lds + XB_LDS_OFF); st[0] = 0u; st[1] = 0u; (void)xb_add(&bar0[XB_XCNT(xb_xcc_id())], 1u); } }
    __syncthreads();
#define XN ((bf16_t*)(ws + WS_XN))
    for (int L = 0; L < DEPTH; ++L) {
        prep_phase(WV, L, lds);
        norm_phase<false>(WV, L == 0 ? (float*)inp(0) : outp(), inp(1) + L * 1024, XN, 0, MTOK, G >= 64 ? bid - 32 : bid, G >= 64 ? G - 32 : G);
        GSYNC();
        {
            pg8::Gemm g{(const char*)XN, (const char*)XN, (const char*)(ws + WS_WIN), MTOK, 3584, 1024, 1024, 1024, 0, 0, 1 << 30};
            pg8::StaticOrder S; S.init(MTOK, 3584, G, bid);
            EpiG1 E{L};
            pg8::gemm_phase<EpiG1>(WV, lds, g, S, E);
            la_phase(WV, L);
        }
        GSYNC();
        {
            pg8::Gemm g{(const char*)(ws + WS_U), (const char*)(ws + WS_U), (const char*)(ws + WS_BTZ), 2048, 8192, 256, 0, 256, 1, 32, 1 << 30};
            pg8::StaticOrder S; S.init(2048, 8192, G, bid);
            EpiZ E{0};
            pg8::gemm_phase<EpiZ>(WV, lds, g, S, E);
            gla_phase<false>(WV, L, lds);
        }
        GSYNC();
        s5_scan_phase(WV, lds);
        gla_scan_phase(WV);
        GSYNC();
        {
            pg8::Gemm g{(const char*)(ws + WS_U), (const char*)(ws + WS_SU) - 4 * 4096, (const char*)(ws + WS_BTY), 2048, 8192, 384, 0, 384, 1, 32, 4};
            pg8::StaticOrder S; S.init(2048, 8192, G, bid);
            EpiY E{L};
            pg8::gemm_phase<EpiY>(WV, lds, g, S, E);
            gla_phase<true>(WV, L, lds);
        }
        GSYNC();
        {
            pg8::Gemm g{(const char*)(ws + WS_U), (const char*)(ws + WS_U), (const char*)(ws + WS_WGLU), MTOK, 1024, 512, 512, 512, 0, 0, 1 << 30};
            pg8::StaticOrder S; S.init(MTOK, 1024, G, bid);
            EpiGLU E{0};
            pg8::gemm_phase<EpiGLU>(WV, lds, g, S, E);
            pg8::Gemm g2{(const char*)XN, (const char*)XN, (const char*)(ws + WS_WIN) + (size_t)3584 * 1024 * 2, MTOK, 2048, 1024, 1024, 1024, 0, 0, 1 << 30};
            pg8::StaticOrder S2; S2.init(MTOK, 2048, G, bid);
            EpiGate E2{0};
            pg8::gemm_phase<EpiGate>(WV, lds, g2, S2, E2);
        }
        GSYNC();
        {
            pg8::Gemm g{(const char*)(ws + WS_VY), (const char*)(ws + WS_VY), (const char*)(ws + WS_WMRG), MTOK, 1024, 1536, 1536, 1536, 0, 0, 1 << 30};
            pg8::StaticOrder S; S.init(MTOK, 1024, G, bid);
            EpiMerge E{0};
            pg8::gemm_phase<EpiMerge>(WV, lds, g, S, E);
        }
        GSYNC();
        {
            pg8::Gemm g{(const char*)(ws + WS_MIX), (const char*)(ws + WS_MIX), (const char*)(ws + WS_WOUT), MTOK, 1024, 1024, 1024, 1024, 0, 0, 1 << 30};
            pg8::StaticOrder S; S.init(MTOK, 1024, G, bid);
            EpiRes E{0, L == 0 ? 1 : 0};
            pg8::gemm_phase<EpiRes>(WV, lds, g, S, E);
        }
        GSYNC();
        norm_phase<false>(WV, outp(), inp(18) + L * 1024, XN, 0, MTOK, bid, G);
        GSYNC();
        {
            pg8::Gemm g{(const char*)XN, (const char*)XN, (const char*)(ws + WS_WGU), MTOK, 2 * DFF, 1024, 1024, 1024, 0, 0, 1 << 30};
            pg8::StaticOrder S; S.init(MTOK, 2 * DFF, G, bid);
            EpiGU E{0};
            pg8::gemm_phase<EpiGU>(WV, lds, g, S, E);
        }
        GSYNC();
        {
            pg8::Gemm g{(const char*)(ws + WS_H), (const char*)(ws + WS_H), (const char*)(ws + WS_WDN), MTOK, 1024, DFF, DFF, DFF, 0, 0, 1 << 30};
            pg8::StaticOrder S; S.init(MTOK, 1024, G, bid);
            EpiRes E{0, 0};
            pg8::gemm_phase<EpiRes>(WV, lds, g, S, E);
        }
        GSYNC();
    }
    norm_phase<true>(WV, outp(), inp(22), nullptr, 0, MTOK, bid, G);
}

#undef ws
#undef XN
extern "C" void kernel_launch(void* const* d_in, const int* in_sizes, int n_in, void* d_out, int out_size, void* d_ws, size_t ws_size, hipStream_t stream) {
    static int grid_blocks = 0;
    if (grid_blocks == 0) {
        if (n_in != 23 || out_size != MTOK * DM || ws_size < WS_END) { fprintf(stderr, "kernel_launch: unexpected shapes (n_in %d out %d ws %zu)\n", n_in, out_size, ws_size); grid_blocks = -1; return; }
        int dev = 0, cus = 0, per_cu = 0;
        hipGetDevice(&dev);
        hipDeviceGetAttribute(&cus, hipDeviceAttributeMultiprocessorCount, dev);
        hipFuncSetAttribute((const void*)fwd_megakernel, hipFuncAttributeMaxDynamicSharedMemorySize, LDS_BYTES);
        hipOccupancyMaxActiveBlocksPerMultiprocessor(&per_cu, (const void*)fwd_megakernel, NTHR, LDS_BYTES);
        if (per_cu < 1) per_cu = 1;
        (void)hipGetLastError();
        grid_blocks = cus * 1;
    }
    if (grid_blocks < 0) return;
    (void)hipMemsetAsync(d_ws, 0, 16384, stream);
    Args a{};
    for (int i = 0; i < 23; ++i) a.in[i] = (const float*)d_in[i];
    a.out = (float*)d_out; a.ws = (unsigned char*)d_ws;
    void* args[] = {&a};
    hipError_t e = hipLaunchCooperativeKernel((const void*)fwd_megakernel, dim3(grid_blocks), dim3(NTHR), args, LDS_BYTES, stream);
    if (e != hipSuccess) fprintf(stderr, "cooperative launch failed: %s (grid %d)\n", hipGetErrorString(e), grid_blocks);
}
```

```cpp
#include <hip/hip_runtime.h>
#include <hip/hip_cooperative_groups.h>
#include <cstdio>
#include <cstdint>
namespace cg = cooperative_groups;

#define LAS __attribute__((address_space(3)))
typedef unsigned short bf16_t;
typedef short bf16x8 __attribute__((ext_vector_type(8)));
typedef float f32x4 __attribute__((ext_vector_type(4)));
typedef float f32x2 __attribute__((ext_vector_type(2)));
typedef unsigned u32x4 __attribute__((ext_vector_type(4)));
typedef unsigned u32x2 __attribute__((ext_vector_type(2)));

constexpr int DM = 1024, MTOK = 32768, MH = 16384, DEPTH = 4, DIN = 5648, NPROJ = 6144, DFF = 2816;
constexpr int NTHR = 512;
constexpr float EPS = 1e-6f;
constexpr size_t MiB = 1u << 20;
constexpr size_t WS_WIN = 1 * MiB, WS_WGLU = 13 * MiB, WS_WMRG = 14 * MiB, WS_WOUT = 17 * MiB, WS_WGU = 19 * MiB, WS_WDN = 30 * MiB;
constexpr size_t WS_BTY = 36 * MiB, WS_BTZ = 42 * MiB, WS_LAM = 46 * MiB;
constexpr size_t WS_WALOW = 46 * MiB + 65536;
constexpr size_t WS_WG2 = 46 * MiB + 131072;
constexpr size_t WS_XN = 48 * MiB;
constexpr size_t WS_U = 112 * MiB, WS_SU = 144 * MiB, WS_Q = 176 * MiB, WS_KB = 208 * MiB, WS_LA = 240 * MiB, WS_VY = 272 * MiB;
constexpr size_t WS_SG = 368 * MiB, WS_Z = 432 * MiB, WS_KV = 464 * MiB, WS_DEC = 496 * MiB;
constexpr size_t WS_R = 144 * MiB, WS_GG = 208 * MiB;
constexpr size_t WS_MIX = 368 * MiB;
constexpr size_t WS_H = 112 * MiB;
constexpr size_t WS_DECC = 497 * MiB;
constexpr size_t WS_END = 498 * MiB;
constexpr int LDS_BYTES = 147456;

__device__ __forceinline__ int ltid_w(int wv) { int t; asm volatile("v_mbcnt_lo_u32_b32 %0, -1, 0\n\tv_mbcnt_hi_u32_b32 %0, -1, %0\n\tv_lshl_or_b32 %0, %1, 6, %0" : "=&v"(t) : "s"(wv)); return t; }
#define ltid() ltid_w(WV)
__device__ __forceinline__ unsigned cvt_pk_bf16(float lo, float hi) { unsigned r; asm volatile("v_cvt_pk_bf16_f32 %0, %1, %2" : "=v"(r) : "v"(lo), "v"(hi)); return r; }
#define MFMA_SETTLE() do { __builtin_amdgcn_sched_barrier(0); asm volatile("s_nop 15\n\ts_nop 7" ::: "memory"); __builtin_amdgcn_sched_barrier(0); } while (0)
__device__ __forceinline__ float bf2f(unsigned short b) { return __uint_as_float(((unsigned)b) << 16); }
__device__ __forceinline__ float bflo(unsigned w) { return __uint_as_float(w << 16); }
__device__ __forceinline__ float bfhi(unsigned w) { return __uint_as_float(w & 0xffff0000u); }
__device__ __forceinline__ unsigned short f2bf(float f) { unsigned u = __float_as_uint(f); u += 0x7fffu + ((u >> 16) & 1u); return (unsigned short)(u >> 16); }
__device__ __forceinline__ float sigm(float x) { return __builtin_amdgcn_rcpf(1.0f + __expf(-x)); }
__device__ __forceinline__ float silu_f(float x) { return x * __builtin_amdgcn_rcpf(1.0f + __expf(-x)); }
__device__ __forceinline__ float gelu_tanh(float x) { const float t = 1.5957691216f * (x + 0.044715f * x * x * x); return x * __builtin_amdgcn_rcpf(1.0f + __expf(-t)); }
__device__ __forceinline__ float logsig(float x) { return fminf(x, 0.f) - 0.69314718056f * __builtin_amdgcn_logf(1.0f + __builtin_amdgcn_exp2f(-1.44269504089f * fabsf(x))); }
__device__ __forceinline__ unsigned pk_h2(float a, float b) { const _Float16 ha = (_Float16)a, hb = (_Float16)b; return (unsigned)__builtin_bit_cast(unsigned short, ha) | ((unsigned)__builtin_bit_cast(unsigned short, hb) << 16); }
__device__ __forceinline__ float h2f(unsigned short h) { return (float)__builtin_bit_cast(_Float16, h); }
__device__ __forceinline__ u32x4 pack8(f32x4 a, f32x4 b) { u32x4 r; r[0] = cvt_pk_bf16(a[0], a[1]); r[1] = cvt_pk_bf16(a[2], a[3]); r[2] = cvt_pk_bf16(b[0], b[1]); r[3] = cvt_pk_bf16(b[2], b[3]); return r; }

namespace pg8 {
constexpr int BM = 256, BK = 64, HALF = 128, HTB = HALF * BK * 2, STAGE_BYTES = 8 * HTB, NXCD = 8, WGM = 8;
__host__ __device__ __forceinline__ int lds_byte(int r, int c) { const int st = (r >> 4) * 2 + (c >> 5), rr = r & 15, cc = c & 31, ob = rr * 64 + cc * 2; return st * 1024 + (ob ^ (((ob >> 9) & 1) << 5)); }
__host__ __device__ __forceinline__ void stage_rc(int b, int& R, int& C) { const int st = b / 1024, sb = b % 1024, swz = sb ^ (((sb >> 9) & 1) << 5); R = (st >> 1) * 16 + swz / 64; C = (st & 1) * 32 + (swz % 64) / 2; }
__host__ __device__ __forceinline__ int perm32(int rho) { const int n = rho >> 4, i = rho & 15; return 8 * (i >> 2) + 4 * n + (i & 3); }

struct Unit { int pm, pn; };
struct Gemm { const char* A; const char* A2; const char* Bt; int M, N, K, lda, ldb, seg, apn, tsw; };

struct StaticOrder {
    int nM, nN, nwg, G, c;
    __device__ __forceinline__ void init(int M, int N, int G_, int c_) { nM = M / BM; nN = N / BM; nwg = nM * nN; G = G_; c = c_; }
    __device__ bool next(int i, Unit& u) const {
        const long L = (long)i * G + c; if (L >= nwg) return false;
        int wgid = (int)L; { const int q = nwg / NXCD, r = nwg % NXCD, xcd = wgid % NXCD, off = wgid / NXCD; wgid = (xcd < r ? xcd * (q + 1) : r * (q + 1) + (xcd - r) * q) + off; }
        const int nig = WGM * nN, gid = wgid / nig, fm = gid * WGM, gsz = (nM - fm) < WGM ? (nM - fm) : WGM;
        u.pm = fm + ((wgid % nig) % gsz); u.pn = (wgid % nig) / gsz; return true;
    }
};

template <class Epi>
__device__ __forceinline__ void gemm_phase(const int WV, LAS unsigned char* lds, const Gemm g, const StaticOrder& S, const Epi& E) {
    const int tid = ltid(), wid = __builtin_amdgcn_readfirstlane(tid >> 6), lane = tid & 63, wr = wid >> 2, wc = wid & 3, fr = lane & 15, fq = lane >> 4;
    const int K = g.K, nt = K / BK;
    const int rsA = g.seg ? 8192 : g.lda;
    unsigned voffA[2], voffB[2];
#pragma unroll
    for (int i = 0; i < 2; ++i) { int R, C; stage_rc(tid * 16 + i * 8192, R, C); const int Rb = Epi::PERM ? ((R & ~31) + perm32(R & 31)) : R;
        voffA[i] = g.seg ? (unsigned)(R * 8192 + (C >> 4) * 512 + (C & 15)) * 2u : (unsigned)(R * g.lda + C) * 2u;
        voffB[i] = (unsigned)(Rb * g.ldb + C) * 2u; }
    const size_t kstepA = g.seg ? (size_t)4096 : (size_t)(BK * 2);
    const size_t kstepB = (size_t)(BK * 2);
    const size_t hstepA = (size_t)HALF * rsA * 2, tstepA = 2 * hstepA;
    const size_t hstepB = (size_t)HALF * g.ldb * 2, tstepB = 2 * hstepB;
    const int tsw = g.tsw;
    const unsigned ldsw = (unsigned)wid * 1024u;
    const int aoff = lds_byte(wr * 64 + fr, fq * 8), boff = lds_byte(wc * 32 + fr, fq * 8);
#define PG8_SA(b, h) (((b) * 2 + (h)) * HTB)
#define PG8_SB(b, h) ((4 + (b) * 2 + (h)) * HTB)
#define PG8_STAGE(bufoff, gbase, voff) do { _Pragma("unroll") for (int _i = 0; _i < 2; ++_i) \
        __builtin_amdgcn_global_load_lds((const unsigned*)((const char*)(gbase) + (voff)[_i]), (LAS unsigned*)(lds + (bufoff) + ldsw + _i * 8192), 16, 0, 0); } while (0)
#define PG8_LDA(dst, b, h) do { _Pragma("unroll") for (int m = 0; m < 4; ++m) _Pragma("unroll") for (int k = 0; k < 2; ++k) dst[m][k] = *(const LAS bf16x8*)(lds + PG8_SA(b, h) + aoff + m * 2048 + k * 1024); } while (0)
#define PG8_LDB(dst, b, h) do { _Pragma("unroll") for (int n = 0; n < 2; ++n) _Pragma("unroll") for (int k = 0; k < 2; ++k) dst[n][k] = *(const LAS bf16x8*)(lds + PG8_SB(b, h) + boff + n * 2048 + k * 1024); } while (0)
#define PG8_MMA(ai, bj, At, Bt) do { __builtin_amdgcn_s_setprio(1); _Pragma("unroll") for (int m = 0; m < 4; ++m) _Pragma("unroll") for (int n = 0; n < 2; ++n) _Pragma("unroll") for (int k = 0; k < 2; ++k) \
        acc[ai][bj][m][n] = __builtin_amdgcn_mfma_f32_16x16x32_bf16(Bt[n][k], At[m][k], acc[ai][bj][m][n], 0, 0, 0); __builtin_amdgcn_s_setprio(0); } while (0)
#define PG8_WAIT_V(n) asm volatile("s_waitcnt vmcnt(" #n ")" ::: "memory")
#define PG8_WAIT_L(n) asm volatile("s_waitcnt lgkmcnt(" #n ")" ::: "memory")
#define PG8_BAR __builtin_amdgcn_s_barrier()
#define PG8_SCHED __builtin_amdgcn_sched_barrier(0)
    Unit cur, nxt; int ui = 0;
    if (!S.next(0, cur)) return;
    f32x4 acc[2][2][4][2];
    float zf; asm volatile("v_mov_b32 %0, 0" : "=v"(zf));
#pragma unroll
    for (int a = 0; a < 2; ++a)
#pragma unroll
        for (int b = 0; b < 2; ++b)
#pragma unroll
            for (int m = 0; m < 4; ++m)
#pragma unroll
                for (int n = 0; n < 2; ++n) acc[a][b][m][n] = (f32x4){zf, zf, zf, zf};
    bf16x8 At[4][2], B0[2][2], B1[2][2];
    size_t offA = (size_t)cur.pm * tstepA + (size_t)cur.pn * g.apn;
    const char* cA = g.A + offA; const char* cA2 = g.A2 + offA; const char* cB = g.Bt + (size_t)cur.pn * tstepB;
    PG8_STAGE(PG8_SB(0, 0), cB, voffB); PG8_STAGE(PG8_SB(0, 1), cB + hstepB, voffB); PG8_STAGE(PG8_SA(0, 0), cA, voffA); PG8_STAGE(PG8_SA(0, 1), cA + hstepA, voffA);
    if (wr == 1) PG8_BAR;
    PG8_WAIT_V(2); PG8_BAR;
    PG8_STAGE(PG8_SB(1, 0), cB + kstepB, voffB); PG8_STAGE(PG8_SA(1, 0), cA + kstepA, voffA); PG8_STAGE(PG8_SB(1, 1), cB + hstepB + kstepB, voffB);
    PG8_WAIT_V(6); PG8_BAR;
    for (;;) {
        const bool has_next = S.next(ui + 1, nxt);
        const size_t noffA = has_next ? (size_t)nxt.pm * tstepA + (size_t)nxt.pn * g.apn : offA;
        const char* nA = g.A + noffA; const char* nB = has_next ? g.Bt + (size_t)nxt.pn * tstepB : cB;
        for (int t = 0; t < nt; t += 2) {
            const bool last = (t == nt - 2);
            if constexpr (Epi::MID) { if (t == Epi::TMID) { MFMA_SETTLE(); const int t_e = ltid(); const int fr_e = t_e & 15, fq_e = (t_e >> 4) & 3; E.mid(acc, cur, wr, wc, fr_e, fq_e); } }
            const char* a1 = ((t + 1) < tsw ? cA : cA2) + (size_t)(t + 1) * kstepA;
            const char* a2 = last ? nA : ((t + 2) < tsw ? cA : cA2) + (size_t)(t + 2) * kstepA;
            const char* a3 = last ? nA + kstepA : ((t + 3) < tsw ? cA : cA2) + (size_t)(t + 3) * kstepA;
            const char* b2 = last ? nB : cB + (size_t)(t + 2) * kstepB;
            const char* b3 = b2 + kstepB;
            PG8_LDB(B0, 0, 0); PG8_LDB(B1, 0, 1); PG8_SCHED; PG8_LDA(At, 0, 0); PG8_STAGE(PG8_SA(1, 1), a1 + hstepA, voffA);
            PG8_WAIT_V(8); PG8_WAIT_L(0); PG8_BAR; PG8_MMA(0, 0, At, B0); PG8_MMA(0, 1, At, B1); PG8_BAR; PG8_SCHED;
            PG8_LDA(At, 0, 1); PG8_STAGE(PG8_SB(0, 0), b2, voffB); PG8_STAGE(PG8_SB(0, 1), b2 + hstepB, voffB); PG8_STAGE(PG8_SA(0, 0), a2, voffA);
            PG8_WAIT_V(8); PG8_WAIT_L(0); PG8_BAR; PG8_MMA(1, 0, At, B0); PG8_MMA(1, 1, At, B1); PG8_BAR; PG8_SCHED;
            PG8_LDB(B0, 1, 0); PG8_LDB(B1, 1, 1); PG8_SCHED; PG8_LDA(At, 1, 0); PG8_STAGE(PG8_SA(0, 1), a2 + hstepA, voffA);
            PG8_WAIT_V(8); PG8_WAIT_L(0); PG8_BAR; PG8_MMA(0, 0, At, B0); PG8_MMA(0, 1, At, B1); PG8_BAR; PG8_SCHED;
            PG8_LDA(At, 1, 1); PG8_STAGE(PG8_SB(1, 0), b3, voffB); PG8_STAGE(PG8_SB(1, 1), b3 + hstepB, voffB); PG8_STAGE(PG8_SA(1, 0), a3, voffA);
            PG8_WAIT_V(8); PG8_WAIT_L(0); PG8_BAR; PG8_MMA(1, 0, At, B0); PG8_MMA(1, 1, At, B1); PG8_BAR; PG8_SCHED;
        }
        if (wr == 0) PG8_BAR;
        MFMA_SETTLE();
        { const int t_e = ltid(); const int fr_e = t_e & 15, fq_e = (t_e >> 4) & 3; E(acc, cur, wr, wc, fr_e, fq_e); }
        if (!has_next) break;
#pragma unroll
        for (int a = 0; a < 2; ++a)
#pragma unroll
            for (int b = 0; b < 2; ++b)
#pragma unroll
                for (int m = 0; m < 4; ++m)
#pragma unroll
                    for (int n = 0; n < 2; ++n) acc[a][b][m][n] = (f32x4){zf, zf, zf, zf};
        cur = nxt; offA = noffA; cA = nA; cA2 = g.A2 + noffA; cB = nB; ++ui;
        if (wr == 1) PG8_BAR;
    }
    PG8_WAIT_V(0);
    PG8_BAR;
#undef PG8_SA
#undef PG8_SB
#undef PG8_STAGE
#undef PG8_LDA
#undef PG8_LDB
#undef PG8_MMA
#undef PG8_WAIT_V
#undef PG8_WAIT_L
#undef PG8_BAR
#undef PG8_SCHED
}
}
using pg8::Unit;
typedef f32x4 Acc[2][2][4][2];

struct Args { const float* in[23]; float* out; unsigned char* ws; };
typedef const __attribute__((address_space(4))) char* kptr_t;
__device__ __forceinline__ kptr_t kbase() { kptr_t k = (kptr_t)__builtin_amdgcn_kernarg_segment_ptr(); asm volatile("" : "+s"(k)); return k; }
__device__ __forceinline__ const float* inp(int i) { return *(const float* const __attribute__((address_space(4)))*)(kbase() + 8 * i); }
__device__ __forceinline__ float* outp() { return *(float* const __attribute__((address_space(4)))*)(kbase() + 8 * 23); }
__device__ __forceinline__ unsigned char* wsp() { return *(unsigned char* const __attribute__((address_space(4)))*)(kbase() + 8 * 24); }


struct EpiG1 {
    static constexpr bool PERM = true, MID = false; static constexpr int TMID = 0;
    int L;
    __device__ __forceinline__ void mid(Acc&, const Unit&, int, int, int, int) const {}
    __device__ __forceinline__ void operator()(const Acc& acc, const Unit& u, int wr, int wc, int fr, int fq) const {
        const int pn = u.pn, row0 = u.pm * 256 + wr * 64 + fr, cw = wc * 32 + 8 * fq;
        unsigned char* const wsb = wsp();
        if (pn < 14) {
            bf16_t* base; int ld; bool dosilu = false;
            if (pn < 2) { base = (bf16_t*)(wsb + WS_U) + pn * 256; ld = 512; }
            else if (pn < 4) { base = (bf16_t*)(wsb + WS_Q) + (pn - 2) * 256; ld = 512; }
            else if (pn < 6) { base = (bf16_t*)(wsb + WS_KB) + (pn - 4) * 256; ld = 512; }
            else if (pn < 10) { base = (bf16_t*)(wsb + WS_VY) + 512 + (pn - 6) * 256; ld = 1536; }
            else { base = (bf16_t*)(wsb + WS_SG) + (pn - 10) * 256; ld = 1024; dosilu = true; }
#pragma unroll
            for (int ai = 0; ai < 2; ++ai)
#pragma unroll
                for (int m = 0; m < 4; ++m) { bf16_t* rowp = base + (size_t)(row0 + ai * 128 + m * 16) * ld + cw;
#pragma unroll
                    for (int bj = 0; bj < 2; ++bj) { f32x4 v0 = acc[ai][bj][m][0], v1 = acc[ai][bj][m][1];
                        if (dosilu) {
#pragma unroll
                            for (int e = 0; e < 4; ++e) { v0[e] = silu_f(v0[e]); v1[e] = silu_f(v1[e]); } }
                        *(u32x4*)(rowp + bj * 128) = pack8(v0, v1); __builtin_amdgcn_sched_barrier(0); } }
        } else {
            const int c0 = (pn - 14) * 256 + cw; const float* const bgate = inp(13) + L * 512; unsigned short* const LA = (unsigned short*)(wsb + WS_LA);
#pragma unroll
            for (int bj = 0; bj < 2; ++bj) { const f32x4 b0 = *(const f32x4*)(bgate + c0 + bj * 128), b1 = *(const f32x4*)(bgate + c0 + bj * 128 + 4);
#pragma unroll
                for (int ai = 0; ai < 2; ++ai)
#pragma unroll
                    for (int m = 0; m < 4; ++m) { const f32x4 v0 = acc[ai][bj][m][0] + b0, v1 = acc[ai][bj][m][1] + b1; u32x4 o;
                        o[0] = pk_h2(logsig(v0[0]) * 0.0625f, logsig(v0[1]) * 0.0625f); o[1] = pk_h2(logsig(v0[2]) * 0.0625f, logsig(v0[3]) * 0.0625f);
                        o[2] = pk_h2(logsig(v1[0]) * 0.0625f, logsig(v1[1]) * 0.0625f); o[3] = pk_h2(logsig(v1[2]) * 0.0625f, logsig(v1[3]) * 0.0625f);
                        *(u32x4*)(LA + (size_t)(row0 + ai * 128 + m * 16) * 512 + c0 + bj * 128) = o; __builtin_amdgcn_sched_barrier(0); } }
        }
    }
};
struct EpiGate {
    static constexpr bool PERM = true, MID = false; static constexpr int TMID = 0;
    int dummy;
    __device__ __forceinline__ void mid(Acc&, const Unit&, int, int, int, int) const {}
    __device__ __forceinline__ void operator()(const Acc& acc, const Unit& u, int wr, int wc, int fr, int fq) const {
        const int row0 = u.pm * 256 + wr * 64 + fr, cw = wc * 32 + 8 * fq;
        unsigned char* const wsb = wsp();
        {
            const int T = u.pn; bf16_t* const R = (bf16_t*)(wsb + WS_R); bf16_t* const GG = (bf16_t*)(wsb + WS_GG);
#pragma unroll
            for (int ai = 0; ai < 2; ++ai)
#pragma unroll
                for (int m = 0; m < 4; ++m) { const size_t o = (size_t)(row0 + ai * 128 + m * 16) * 1024 + T * 128 + cw;
                    f32x4 r0, r1, g0, g1;
#pragma unroll
                    for (int e = 0; e < 4; ++e) {
                        const float ea0 = __expf(-acc[ai][0][m][0][e]), eb0 = __expf(-acc[ai][1][m][0][e]);
                        const float ea1 = __expf(-acc[ai][0][m][1][e]), eb1 = __expf(-acc[ai][1][m][1][e]);
                        const float ta0 = 1.0f + ea0, tb0 = 1.0f + eb0, ta1 = 1.0f + ea1, tb1 = 1.0f + eb1;
                        const float q0 = __builtin_amdgcn_rcpf(ta0 * tb0), q1 = __builtin_amdgcn_rcpf(ta1 * tb1);
                        g0[e] = q0 * ta0; g1[e] = q1 * ta1; r0[e] = q0 * tb0 * tb0; r1[e] = q1 * tb1 * tb1; }
                    *(u32x4*)(R + o) = pack8(r0, r1); *(u32x4*)(GG + o) = pack8(g0, g1); __builtin_amdgcn_sched_barrier(0); }
        }
    }
};
struct EpiZ {
    static constexpr bool PERM = false, MID = false; static constexpr int TMID = 0;
    int dummy;
    __device__ __forceinline__ void mid(Acc&, const Unit&, int, int, int, int) const {}
    __device__ __forceinline__ void operator()(const Acc& acc, const Unit& u, int wr, int wc, int fr, int fq) const {
        float* const Z = (float*)(wsp() + WS_Z);
        const int g = u.pn, row0 = u.pm * 256 + wr * 64 + fr, c0 = wc * 32 + 4 * fq;
#pragma unroll
        for (int ai = 0; ai < 2; ++ai)
#pragma unroll
            for (int m = 0; m < 4; ++m) { float* p = Z + ((size_t)(row0 + ai * 128 + m * 16) * 32 + g) * 128 + c0;
#pragma unroll
                for (int n = 0; n < 2; ++n) *(f32x4*)(p + n * 16) = acc[ai][0][m][n]; }
    }
};
struct EpiY {
    static constexpr bool PERM = true, MID = false; static constexpr int TMID = 0;
    int L;
    __device__ __forceinline__ void mid(Acc&, const Unit&, int, int, int, int) const {}
    __device__ __forceinline__ void operator()(const Acc& acc, const Unit& u, int wr, int wc, int fr, int fq) const {
        const int g = u.pn, row0 = u.pm * 256 + wr * 64 + fr, c0 = 8 * (fq & 1);
        bf16_t* const U = (bf16_t*)(wsp() + WS_U); const float* const D = inp(10) + L * 512;
        const f32x4 d0 = *(const f32x4*)(D + g * 16 + c0), d1 = *(const f32x4*)(D + g * 16 + c0 + 4);
#pragma unroll
        for (int ai = 0; ai < 2; ++ai) {
            u32x4 uv[4][2];
#pragma unroll
            for (int m = 0; m < 4; ++m)
#pragma unroll
                for (int bj = 0; bj < 2; ++bj) uv[m][bj] = *(const u32x4*)(U + (size_t)(16 * (row0 + ai * 128 + m * 16) + 8 * bj + 2 * wc + (fq >> 1)) * 512 + g * 16 + c0);
            __builtin_amdgcn_sched_barrier(0);
#pragma unroll
            for (int m = 0; m < 4; ++m)
#pragma unroll
                for (int bj = 0; bj < 2; ++bj) { bf16_t* p = U + (size_t)(16 * (row0 + ai * 128 + m * 16) + 8 * bj + 2 * wc + (fq >> 1)) * 512 + g * 16 + c0;
                    const u32x4 w4 = uv[m][bj]; f32x4 v0 = acc[ai][bj][m][0], v1 = acc[ai][bj][m][1];
                    v0[0] += d0[0] * bflo(w4[0]); v0[1] += d0[1] * bfhi(w4[0]); v0[2] += d0[2] * bflo(w4[1]); v0[3] += d0[3] * bfhi(w4[1]);
                    v1[0] += d1[0] * bflo(w4[2]); v1[1] += d1[1] * bfhi(w4[2]); v1[2] += d1[2] * bflo(w4[3]); v1[3] += d1[3] * bfhi(w4[3]);
#pragma unroll
                    for (int e = 0; e < 4; ++e) { v0[e] = gelu_tanh(v0[e]); v1[e] = gelu_tanh(v1[e]); }
                    *(u32x4*)p = pack8(v0, v1); }
            __builtin_amdgcn_sched_barrier(0); }
    }
};
struct EpiGLU {
    static constexpr bool PERM = true, MID = false; static constexpr int TMID = 0;
    int dummy;
    __device__ __forceinline__ void mid(Acc&, const Unit&, int, int, int, int) const {}
    __device__ __forceinline__ void operator()(const Acc& acc, const Unit& u, int wr, int wc, int fr, int fq) const {
        bf16_t* const VY = (bf16_t*)(wsp() + WS_VY);
        const int row0 = u.pm * 256 + wr * 64 + fr, c0 = u.pn * 128 + wc * 32 + 8 * fq;
#pragma unroll
        for (int ai = 0; ai < 2; ++ai)
#pragma unroll
            for (int m = 0; m < 4; ++m) { f32x4 v0, v1;
#pragma unroll
                for (int e = 0; e < 4; ++e) { v0[e] = acc[ai][0][m][0][e] * sigm(acc[ai][1][m][0][e]); v1[e] = acc[ai][0][m][1][e] * sigm(acc[ai][1][m][1][e]); }
                *(u32x4*)(VY + (size_t)(row0 + ai * 128 + m * 16) * 1536 + c0) = pack8(v0, v1); __builtin_amdgcn_sched_barrier(0); }
    }
};
struct EpiMerge {
    static constexpr bool PERM = true, MID = true; static constexpr int TMID = 8;
    int dummy;
    __device__ __forceinline__ void mid(Acc& acc, const Unit& u, int wr, int wc, int fr, int fq) const {
        const bf16_t* const R = (const bf16_t*)(wsp() + WS_R);
        const int row0 = u.pm * 256 + wr * 64 + fr, c0 = u.pn * 256 + wc * 32 + 8 * fq;
#pragma unroll
        for (int ai = 0; ai < 2; ++ai) {
            u32x4 rv[4][2];
#pragma unroll
            for (int m = 0; m < 4; ++m)
#pragma unroll
                for (int bj = 0; bj < 2; ++bj) rv[m][bj] = *(const u32x4*)(R + (size_t)(row0 + ai * 128 + m * 16) * 1024 + c0 + bj * 128);
            __builtin_amdgcn_sched_barrier(0);
#pragma unroll
            for (int m = 0; m < 4; ++m)
#pragma unroll
                for (int bj = 0; bj < 2; ++bj) { const u32x4 r4 = rv[m][bj];
                    acc[ai][bj][m][0][0] *= bflo(r4[0]); acc[ai][bj][m][0][1] *= bfhi(r4[0]); acc[ai][bj][m][0][2] *= bflo(r4[1]); acc[ai][bj][m][0][3] *= bfhi(r4[1]);
                    acc[ai][bj][m][1][0] *= bflo(r4[2]); acc[ai][bj][m][1][1] *= bfhi(r4[2]); acc[ai][bj][m][1][2] *= bflo(r4[3]); acc[ai][bj][m][1][3] *= bfhi(r4[3]); }
            __builtin_amdgcn_sched_barrier(0); }
    }
    __device__ __forceinline__ void operator()(const Acc& acc, const Unit& u, int wr, int wc, int fr, int fq) const {
        const bf16_t* const GG = (const bf16_t*)(wsp() + WS_GG); bf16_t* const MIX = (bf16_t*)(wsp() + WS_MIX);
        const int row0 = u.pm * 256 + wr * 64 + fr, c0 = u.pn * 256 + wc * 32 + 8 * fq;
#pragma unroll
        for (int ai = 0; ai < 2; ++ai) {
            u32x4 gq[4][2];
#pragma unroll
            for (int m = 0; m < 4; ++m)
#pragma unroll
                for (int bj = 0; bj < 2; ++bj) gq[m][bj] = *(const u32x4*)(GG + (size_t)(row0 + ai * 128 + m * 16) * 1024 + c0 + bj * 128);
            __builtin_amdgcn_sched_barrier(0);
#pragma unroll
            for (int m = 0; m < 4; ++m)
#pragma unroll
                for (int bj = 0; bj < 2; ++bj) { const size_t o = (size_t)(row0 + ai * 128 + m * 16) * 1024 + c0 + bj * 128; const u32x4 gv = gq[m][bj];
                    f32x4 v0 = acc[ai][bj][m][0], v1 = acc[ai][bj][m][1];
                    v0[0] *= bflo(gv[0]); v0[1] *= bfhi(gv[0]); v0[2] *= bflo(gv[1]); v0[3] *= bfhi(gv[1]);
                    v1[0] *= bflo(gv[2]); v1[1] *= bfhi(gv[2]); v1[2] *= bflo(gv[3]); v1[3] *= bfhi(gv[3]);
                    *(u32x4*)(MIX + o) = pack8(v0, v1); }
            __builtin_amdgcn_sched_barrier(0); }
    }
};
struct EpiRes {
    static constexpr bool PERM = false, MID = false; static constexpr int TMID = 0;
    int m0, fromx;
    __device__ __forceinline__ void mid(Acc&, const Unit&, int, int, int, int) const {}
    __device__ __forceinline__ void operator()(const Acc& acc, const Unit& u, int wr, int wc, int fr, int fq) const {
        float* const Hres = outp() + (size_t)m0 * 1024; const float* const Hsrc = (fromx ? inp(0) : (const float*)outp()) + (size_t)m0 * 1024;
        const int row0 = u.pm * 256 + wr * 64 + fr, c0 = u.pn * 256 + wc * 32 + 4 * fq;
#pragma unroll
        for (int ai = 0; ai < 2; ++ai)
#pragma unroll
            for (int mh = 0; mh < 2; ++mh) {
                f32x4 hv[2][2][2];
#pragma unroll
                for (int mm = 0; mm < 2; ++mm)
#pragma unroll
                    for (int bj = 0; bj < 2; ++bj)
#pragma unroll
                        for (int n = 0; n < 2; ++n) hv[mm][bj][n] = *(const f32x4*)(Hsrc + (size_t)(row0 + ai * 128 + (2 * mh + mm) * 16) * 1024 + c0 + bj * 128 + n * 16);
                __builtin_amdgcn_sched_barrier(0);
#pragma unroll
                for (int mm = 0; mm < 2; ++mm)
#pragma unroll
                    for (int bj = 0; bj < 2; ++bj)
#pragma unroll
                        for (int n = 0; n < 2; ++n) *(f32x4*)(Hres + (size_t)(row0 + ai * 128 + (2 * mh + mm) * 16) * 1024 + c0 + bj * 128 + n * 16) = hv[mm][bj][n] + acc[ai][bj][2 * mh + mm][n];
                __builtin_amdgcn_sched_barrier(0); }
    }
};
struct EpiGU {
    static constexpr bool PERM = true, MID = false; static constexpr int TMID = 0;
    int dummy;
    __device__ __forceinline__ void mid(Acc&, const Unit&, int, int, int, int) const {}
    __device__ __forceinline__ void operator()(const Acc& acc, const Unit& u, int wr, int wc, int fr, int fq) const {
        bf16_t* const H = (bf16_t*)(wsp() + WS_H);
        const int row0 = u.pm * 256 + wr * 64 + fr, c0 = u.pn * 128 + wc * 32 + 8 * fq;
#pragma unroll
        for (int ai = 0; ai < 2; ++ai)
#pragma unroll
            for (int m = 0; m < 4; ++m) { f32x4 v0, v1;
#pragma unroll
                for (int e = 0; e < 4; ++e) { v0[e] = silu_f(acc[ai][0][m][0][e]) * acc[ai][1][m][0][e]; v1[e] = silu_f(acc[ai][0][m][1][e]) * acc[ai][1][m][1][e]; }
                *(u32x4*)(H + (size_t)(row0 + ai * 128 + m * 16) * DFF + c0) = pack8(v0, v1); __builtin_amdgcn_sched_barrier(0); }
    }
};

__device__ __forceinline__ float shx(float v, int o, int lane) { return __builtin_bit_cast(float, __builtin_amdgcn_ds_bpermute((lane ^ o) << 2, __builtin_bit_cast(int, v))); }
__device__ __forceinline__ float wave_sum(float v, int lane) {
#pragma unroll
    for (int o = 32; o > 0; o >>= 1) v += shx(v, o, lane);
    return v;
}

template <bool FINAL>
__device__ __forceinline__ void norm_phase(const int WV, float* h, const float* g, bf16_t* xn, int r0, int r1, int blk, int nblk) {
    const int tid0 = ltid(), lane = tid0 & 63, wave = tid0 >> 6;
    f32x4 gv[4];
#pragma unroll
    for (int i = 0; i < 4; ++i) gv[i] = *(const f32x4*)(g + i * 256 + lane * 4);
    const int stride = nblk * 8;
    for (int row = (blk >= 0 ? r0 + blk * 8 + wave : r1); row < r1; row += 2 * stride) {
        const int row2 = row + stride; const bool has2 = row2 < r1;
        float* p = h + (size_t)row * 1024; float* p2 = h + (size_t)(has2 ? row2 : row) * 1024;
        f32x4 v[4], v2[4]; float ss = 0.f, ss2 = 0.f;
#pragma unroll
        for (int i = 0; i < 4; ++i) { v[i] = *(const f32x4*)(p + i * 256 + lane * 4); v2[i] = *(const f32x4*)(p2 + i * 256 + lane * 4); }
#pragma unroll
        for (int i = 0; i < 4; ++i) { ss += v[i][0] * v[i][0] + v[i][1] * v[i][1] + v[i][2] * v[i][2] + v[i][3] * v[i][3]; ss2 += v2[i][0] * v2[i][0] + v2[i][1] * v2[i][1] + v2[i][2] * v2[i][2] + v2[i][3] * v2[i][3]; }
        ss = wave_sum(ss, lane); ss2 = wave_sum(ss2, lane);
        const float rs = rsqrtf(ss * (1.0f / 1024.0f) + EPS), rs2 = rsqrtf(ss2 * (1.0f / 1024.0f) + EPS);
#pragma unroll
        for (int i = 0; i < 4; ++i) { f32x4 o;
#pragma unroll
            for (int e = 0; e < 4; ++e) o[e] = v[i][e] * rs * gv[i][e];
            if (FINAL) *(f32x4*)(p + i * 256 + lane * 4) = o;
            else { u32x2 w; w[0] = cvt_pk_bf16(o[0], o[1]); w[1] = cvt_pk_bf16(o[2], o[3]); *(u32x2*)(xn + (size_t)row * 1024 + i * 256 + lane * 4) = w; } }
        if (has2) {
#pragma unroll
            for (int i = 0; i < 4; ++i) { f32x4 o;
#pragma unroll
                for (int e = 0; e < 4; ++e) o[e] = v2[i][e] * rs2 * gv[i][e];
                if (FINAL) *(f32x4*)(p2 + i * 256 + lane * 4) = o;
                else { u32x2 w; w[0] = cvt_pk_bf16(o[0], o[1]); w[1] = cvt_pk_bf16(o[2], o[3]); *(u32x2*)(xn + (size_t)row2 * 1024 + i * 256 + lane * 4) = w; } }
        }
    }
}

__device__ __forceinline__ void xpose_tile(const int WV, LAS unsigned char* lds, const float* src, int lds_src, int col0, bf16_t* dst, int ldd, int row0, int k0, int dk0, float scale) {
    LAS float* T = (LAS float*)lds;
    const int tid = ltid();
    __syncthreads();
#pragma unroll
    for (int i = 0; i < 2; ++i) { const int r = (tid >> 4) + 32 * i, c4 = (tid & 15) * 4;
        const f32x4 v = *(const f32x4*)(src + (size_t)(k0 + r) * lds_src + col0 + c4);
        T[(c4 + 0) * 65 + r] = v[0]; T[(c4 + 1) * 65 + r] = v[1]; T[(c4 + 2) * 65 + r] = v[2]; T[(c4 + 3) * 65 + r] = v[3]; }
    __syncthreads();
    const int c = tid >> 3, kc = (tid & 7) * 8;
    u32x4 o;
#pragma unroll
    for (int e = 0; e < 4; ++e) o[e] = cvt_pk_bf16(T[c * 65 + kc + 2 * e] * scale, T[c * 65 + kc + 2 * e + 1] * scale);
    *(u32x4*)(dst + (size_t)(row0 + c) * ldd + dk0 + k0 + kc) = o;
}

__device__ __forceinline__ void xpose_item(int lane, LAS float* scr, const float* src, int ld_src, int col0, bf16_t* dst, int ldd, int row0, int k0, int dk0, float scale) {
#pragma unroll 8
    for (int i = 0; i < 32; ++i) { const int kk = 2 * i + (lane >> 5); scr[kk * 33 + (lane & 31)] = src[(size_t)(k0 + kk) * ld_src + col0 + (lane & 31)] * scale; }
    asm volatile("s_waitcnt lgkmcnt(0)" ::: "memory");
    const int c = lane & 7;
#pragma unroll
    for (int j = 0; j < 4; ++j) { const int n = (lane >> 3) + 8 * j; const LAS float* t = scr + (8 * c) * 33 + n;
        u32x4 o; o[0] = cvt_pk_bf16(t[0 * 33], t[1 * 33]); o[1] = cvt_pk_bf16(t[2 * 33], t[3 * 33]); o[2] = cvt_pk_bf16(t[4 * 33], t[5 * 33]); o[3] = cvt_pk_bf16(t[6 * 33], t[7 * 33]);
        *(u32x4*)(dst + (size_t)(row0 + n) * ldd + dk0 + k0 + 8 * c) = o; }
    asm volatile("s_waitcnt lgkmcnt(0)" ::: "memory");
}
__device__ __forceinline__ void prep_phase(const int WV, int L, LAS unsigned char* lds) {
    unsigned char* ws = wsp();
    bf16_t* WIN = (bf16_t*)(ws + WS_WIN); bf16_t* WGLU = (bf16_t*)(ws + WS_WGLU); bf16_t* WMRG = (bf16_t*)(ws + WS_WMRG); bf16_t* WOUT = (bf16_t*)(ws + WS_WOUT);
    bf16_t* WGU = (bf16_t*)(ws + WS_WGU); bf16_t* WDN = (bf16_t*)(ws + WS_WDN); bf16_t* BTY = (bf16_t*)(ws + WS_BTY); bf16_t* BTZ = (bf16_t*)(ws + WS_BTZ); float* LAM = (float*)(ws + WS_LAM);
    const float* w_in = inp(2) + (size_t)L * DM * DIN;
    const float* w_glu = inp(11) + (size_t)L * 512 * 1024;
    const float* w_bs5 = inp(15) + (size_t)L * 512 * 1024;
    const float* w_bgla = inp(16) + (size_t)L * 1024 * 1024;
    const float* w_out = inp(17) + (size_t)L * 1024 * 1024;
    const float* w_fg = inp(19) + (size_t)L * DM * DFF;
    const float* w_fu = inp(20) + (size_t)L * DM * DFF;
    const float* w_fd = inp(21) + (size_t)L * DFF * DM;
    const float* w_gup = inp(12) + (size_t)L * 16 * 512;
    constexpr int J_WIN = 176 * 16, J_GLU = 32 * 8, J_M1 = 32 * 8, J_M2 = 32 * 16, J_OUT = 32 * 16, J_GU = 176 * 16, J_DN = 32 * 44;
    constexpr int J_TOT = J_WIN + J_GLU + J_M1 + J_M2 + J_OUT + J_GU + J_DN;
    const int nS5 = (gridDim.x >= 64) ? 32 : 0;
    const int wblk = (int)blockIdx.x - nS5, nwblk = (int)gridDim.x - nS5;
    {
        const int tidx = ltid(), xlane = tidx & 63, xwave = tidx >> 6;
        LAS float* scr = (LAS float*)(lds + xwave * 8448);
        for (int job = wblk * 8 + xwave; wblk >= 0 && job < J_TOT; job += nwblk * 8) {
            int j = job;
            if (j < J_WIN) { const int nt = j >> 4, kt = j & 15, n0 = nt * 32; int col0; float sc = 1.f;
                if (n0 < 3584) { col0 = n0; if (n0 >= 512 && n0 < 1024) sc = 0.08838834764831845f; }
                else { const int T = (n0 - 3584) >> 8, jj = (n0 - 3584) & 255; col0 = (jj < 128) ? (3600 + 128 * T + jj) : (4624 + 128 * T + jj - 128); }
                xpose_item(xlane, scr, w_in, DIN, col0, WIN, 1024, n0, kt * 64, 0, sc); continue; }
            j -= J_WIN;
            if (j < J_GLU) { const int nt = j >> 3, kt = j & 7, n0 = nt * 32, T = n0 >> 8, jj = n0 & 255; const int col0 = (jj < 128) ? (128 * T + jj) : (512 + 128 * T + jj - 128);
                xpose_item(xlane, scr, w_glu, 1024, col0, WGLU, 512, n0, kt * 64, 0, 1.f); continue; }
            j -= J_GLU;
            if (j < J_M1) { const int nt = j >> 3, kt = j & 7; xpose_item(xlane, scr, w_bs5, 1024, nt * 32, WMRG, 1536, nt * 32, kt * 64, 0, 1.f); continue; }
            j -= J_M1;
            if (j < J_M2) { const int nt = j >> 4, kt = j & 15; xpose_item(xlane, scr, w_bgla, 1024, nt * 32, WMRG, 1536, nt * 32, kt * 64, 512, 1.f); continue; }
            j -= J_M2;
            if (j < J_OUT) { const int nt = j >> 4, kt = j & 15; xpose_item(xlane, scr, w_out, 1024, nt * 32, WOUT, 1024, nt * 32, kt * 64, 0, 1.f); continue; }
            j -= J_OUT;
            if (j < J_GU) { const int nt = j >> 4, kt = j & 15, n0 = nt * 32, T = n0 >> 8, jj = n0 & 255;
                if (jj < 128) xpose_item(xlane, scr, w_fg, DFF, 128 * T + jj, WGU, 1024, n0, kt * 64, 0, 1.f);
                else xpose_item(xlane, scr, w_fu, DFF, 128 * T + jj - 128, WGU, 1024, n0, kt * 64, 0, 1.f);
                continue; }
            j -= J_GU;
            { const int nt = j / 44, kt = j % 44; xpose_item(xlane, scr, w_fd, 1024, nt * 32, WDN, DFF, nt * 32, kt * 64, 0, 1.f); }
        }
    }
    {
        bf16_t* WALOW = (bf16_t*)(ws + WS_WALOW); u32x2* WG2 = (u32x2*)(ws + WS_WG2);
        const int e = wblk * NTHR + ltid();
        if (wblk >= 0 && e < 16 * 1024) { const int r = e >> 10, k = e & 1023; WALOW[r * 1024 + k] = f2bf(w_in[(size_t)k * DIN + 3584 + r]); }
        if (wblk >= 0 && e < 32 * 64) { const int nt = e >> 6, l = e & 63, cfr = l & 15, cfq = l >> 4; const float* wg = w_gup + (4 * cfq) * 512 + nt * 16 + cfr;
            u32x2 t; t[0] = (unsigned)f2bf(wg[0]) | ((unsigned)f2bf(wg[512]) << 16); t[1] = (unsigned)f2bf(wg[1024]) | ((unsigned)f2bf(wg[1536]) << 16); WG2[e] = t; }
    }
    __syncthreads();
    LAS float* PW = (LAS float*)lds;
    LAS float* BB = PW + 17 * 64 * 2;
    LAS float* CC = BB + 64 * 16 * 2;
    LAS float* KJ = CC + 16 * 64 * 2;
    const int tid = ltid();
    for (int g = blockIdx.x; g < 32 && (nS5 == 0 || (int)blockIdx.x < nS5); g += (nS5 ? nS5 : (int)gridDim.x)) {
        __syncthreads();
        const float dt = __expf(inp(5)[L * 32 + g]);
        if (tid < 64) { const int p = tid; const float ar = inp(3)[(L * 32 + g) * 64 + p], ai = inp(4)[(L * 32 + g) * 64 + p]; const float zr = ar * dt, zi = ai * dt;
            for (int j = 0; j <= 16; ++j) { const float mag = __expf((float)j * zr), ang = (float)j * zi; PW[(j * 64 + p) * 2] = mag * __cosf(ang); PW[(j * 64 + p) * 2 + 1] = mag * __sinf(ang); }
            const float xr = PW[(64 + p) * 2] - 1.0f, xi = PW[(64 + p) * 2 + 1], den = 1.0f / (ar * ar + ai * ai);
            const float cr = (xr * ar + xi * ai) * den, ci = (xi * ar - xr * ai) * den;
            LAM[(g * 64 + p) * 2] = PW[(16 * 64 + p) * 2]; LAM[(g * 64 + p) * 2 + 1] = PW[(16 * 64 + p) * 2 + 1];
            for (int c = 0; c < 16; ++c) { const float br = inp(6)[((size_t)(L * 32 + g) * 64 + p) * 16 + c], bi = inp(7)[((size_t)(L * 32 + g) * 64 + p) * 16 + c];
                BB[(p * 16 + c) * 2] = cr * br - ci * bi; BB[(p * 16 + c) * 2 + 1] = cr * bi + ci * br; } }
        for (int e = tid; e < 1024; e += NTHR) { CC[e * 2] = inp(8)[(size_t)(L * 32 + g) * 1024 + e]; CC[e * 2 + 1] = inp(9)[(size_t)(L * 32 + g) * 1024 + e]; }
        __syncthreads();
        for (int e = tid; e < 4096; e += NTHR) { const int j = e >> 8, c = (e >> 4) & 15, c2 = e & 15; float s = 0.f;
            for (int p = 0; p < 64; ++p) { const float cr = CC[(c * 64 + p) * 2], ci = CC[(c * 64 + p) * 2 + 1], pr = PW[(j * 64 + p) * 2], pi = PW[(j * 64 + p) * 2 + 1];
                const float tr = cr * pr - ci * pi, ti = cr * pi + ci * pr; s += tr * BB[(p * 16 + c2) * 2] - ti * BB[(p * 16 + c2) * 2 + 1]; }
            KJ[e] = s; }
        __syncthreads();
        for (int e = tid; e < 256 * 384; e += NTHR) { const int n = e / 384, k = e % 384, t = n >> 4, c = n & 15; float v;
            if (k < 256) { const int tau = k >> 4, c2 = k & 15; v = (tau <= t) ? KJ[((t - tau) * 16 + c) * 16 + c2] : 0.f; }
            else { const int q = k - 256, p = q & 63; const float cr = CC[(c * 64 + p) * 2], ci = CC[(c * 64 + p) * 2 + 1], pr = PW[((t + 1) * 64 + p) * 2], pi = PW[((t + 1) * 64 + p) * 2 + 1];
                v = (q < 64) ? (cr * pr - ci * pi) : -(cr * pi + ci * pr); }
            BTY[(size_t)g * 256 * 384 + e] = f2bf(v); }
        for (int e = tid; e < 256 * 256; e += NTHR) { const int n = e >> 8, k = e & 255, tau = k >> 4, c2 = k & 15; float v = 0.f;
            if (n < 128) { const int p = n & 63; const float pr = PW[((15 - tau) * 64 + p) * 2], pi = PW[((15 - tau) * 64 + p) * 2 + 1], br = BB[(p * 16 + c2) * 2], bi = BB[(p * 16 + c2) * 2 + 1];
                v = (n < 64) ? (pr * br - pi * bi) : (pr * bi + pi * br); }
            BTZ[(size_t)g * 65536 + e] = f2bf(v); }
    }
    __syncthreads();
}

__device__ __forceinline__ void s5_scan_phase(const int WV, LAS unsigned char* lds) {
    const float* Z = (const float*)(wsp() + WS_Z); const float* LAM = (const float*)(wsp() + WS_LAM); bf16_t* SU = (bf16_t*)(wsp() + WS_SU);
    LAS float* SEG = (LAS float*)lds;
    const int tid = ltid(), p = tid & 63, seg = tid >> 6;
    for (int unit = blockIdx.x; unit < 256; unit += gridDim.x) {
        const int b = unit >> 5, g = unit & 31;
        const float lr = LAM[(g * 64 + p) * 2], li = LAM[(g * 64 + p) * 2 + 1];
        const int j0 = b * 256 + seg * 32;
        float zr[32], zi[32];
#pragma unroll
        for (int s = 0; s < 32; ++s) { const float* zp = Z + ((size_t)(j0 + s) * 32 + g) * 128; zr[s] = zp[p]; zi[s] = zp[64 + p]; }
        float er = 0.f, ei = 0.f;
#pragma unroll
        for (int s = 0; s < 32; ++s) { const float nr = lr * er - li * ei + zr[s], ni = lr * ei + li * er + zi[s]; er = nr; ei = ni; }
        __syncthreads();
        SEG[(seg * 64 + p) * 2] = er; SEG[(seg * 64 + p) * 2 + 1] = ei;
        __syncthreads();
        float l32r = lr, l32i = li;
#pragma unroll
        for (int q = 0; q < 5; ++q) { const float nr = l32r * l32r - l32i * l32i, ni = 2.f * l32r * l32i; l32r = nr; l32i = ni; }
        float cr = 0.f, ci = 0.f;
        for (int s2 = 0; s2 < seg; ++s2) { const float sr = SEG[(s2 * 64 + p) * 2], si = SEG[(s2 * 64 + p) * 2 + 1]; const float nr = l32r * cr - l32i * ci + sr, ni = l32r * ci + l32i * cr + si; cr = nr; ci = ni; }
#pragma unroll
        for (int s = 0; s < 32; ++s) { const int j = j0 + s;
            SU[(size_t)(16 * j + (p >> 4)) * 512 + g * 16 + (p & 15)] = f2bf(cr);
            SU[(size_t)(16 * j + 4 + (p >> 4)) * 512 + g * 16 + (p & 15)] = f2bf(ci);
            const float nr = lr * cr - li * ci + zr[s], ni = lr * ci + li * cr + zi[s]; cr = nr; ci = ni; }
    }
}

__device__ __forceinline__ void la_phase(const int WV, int L) {
    unsigned char* ws = wsp();
    const bf16_t* XNp = (const bf16_t*)(ws + WS_XN); const bf16_t* WALOW = (const bf16_t*)(ws + WS_WALOW); const u32x2* WG2 = (const u32x2*)(ws + WS_WG2);
    const float* bgate = inp(13) + L * 512; unsigned short* LAo = (unsigned short*)(ws + WS_LA);
    const int tid = ltid(), lane = tid & 63, wave = tid >> 6, fr = lane & 15, fq = lane >> 4;
    for (int tile = blockIdx.x * 8 + wave; tile < MTOK / 16; tile += gridDim.x * 8) {
        const int tok0 = tile * 16;
        float zf; asm volatile("v_mov_b32 %0, 0" : "=v"(zf));
        f32x4 acc = (f32x4){zf, zf, zf, zf};
        const bf16_t* ap = WALOW + (size_t)fr * 1024 + 8 * fq; const bf16_t* bp = XNp + (size_t)(tok0 + fr) * 1024 + 8 * fq;
#pragma unroll 8
        for (int ks = 0; ks < 32; ++ks) { const bf16x8 aW = *(const bf16x8*)(ap + 32 * ks), bX = *(const bf16x8*)(bp + 32 * ks);
            acc = __builtin_amdgcn_mfma_f32_16x16x32_bf16(aW, bX, acc, 0, 0, 0); }
        MFMA_SETTLE();
        const u32x4 a2 = (u32x4){cvt_pk_bf16(acc[0], acc[1]), cvt_pk_bf16(acc[2], acc[3]), 0u, 0u};
        const bf16x8 A2 = __builtin_bit_cast(bf16x8, a2);
        unsigned short* lrow = LAo + (size_t)(tok0 + fr) * 512 + 4 * fq;
#pragma unroll 4
        for (int nt = 0; nt < 32; ++nt) { const u32x2 w2 = WG2[nt * 64 + lane]; const u32x4 b4 = (u32x4){w2[0], w2[1], 0u, 0u};
            const f32x4 d = __builtin_amdgcn_mfma_f32_16x16x32_bf16(__builtin_bit_cast(bf16x8, b4), A2, (f32x4){zf, zf, zf, zf}, 0, 0, 0);
            const f32x4 bb = *(const f32x4*)(bgate + nt * 16 + 4 * fq);
            u32x2 o; o[0] = pk_h2(logsig(d[0] + bb[0]) * 0.0625f, logsig(d[1] + bb[1]) * 0.0625f); o[1] = pk_h2(logsig(d[2] + bb[2]) * 0.0625f, logsig(d[3] + bb[3]) * 0.0625f);
            *(u32x2*)(lrow + nt * 16) = o; }
    }
}
constexpr int GL_KT = 0, GL_VT = 18432, GL_QS = 55296, GL_DEC = 72704, GL_PART = 73216, GL_RED = 75264;
template <bool WITH_O>
__device__ __forceinline__ void gla_phase(const int WV, int L, LAS unsigned char* lds) {
    unsigned char* ws = wsp();
    const bf16_t* Q = (const bf16_t*)(ws + WS_Q); const bf16_t* KB = (const bf16_t*)(ws + WS_KB); const unsigned short* LA = (const unsigned short*)(ws + WS_LA);
    bf16_t* VY = (bf16_t*)(ws + WS_VY); const bf16_t* SG = (const bf16_t*)(ws + WS_SG); u32x2* KV = (u32x2*)(ws + WS_KV); float* DEC = (float*)(ws + WS_DEC); float* DECC = (float*)(ws + WS_DECC);
    const float* ng = inp(14) + (size_t)L * 1024;
    const int tid = ltid(), lane = tid & 63, w = tid >> 6, fr = lane & 15, fq = lane >> 4;
    const int kk = tid & 127, tq = tid >> 7;
    LAS float* DECS = (LAS float*)(lds + GL_DEC); LAS float* PART = (LAS float*)(lds + GL_PART); LAS float* RED = (LAS float*)(lds + GL_RED);
    for (int unit = blockIdx.x; unit < 512; unit += gridDim.x) {
        const int h = unit & 3, sc = (unit >> 2) & 15, b = unit >> 6;
        const int t0 = b * 4096 + sc * 256;
        float zf; asm volatile("v_mov_b32 %0, 0" : "=v"(zf));
        f32x4 S[8][2];
#pragma unroll
        for (int mt = 0; mt < 8; ++mt)
#pragma unroll
            for (int nt = 0; nt < 2; ++nt) { if (WITH_O) { const u32x2 kw = KV[((size_t)unit * 16 + mt * 2 + nt) * 512 + tid]; S[mt][nt] = (f32x4){bflo(kw[0]), bfhi(kw[0]), bflo(kw[1]), bfhi(kw[1])}; } else S[mt][nt] = (f32x4){zf, zf, zf, zf}; }
        float dprod = 1.0f;
        unsigned short la_r[16], k_r[16]; u32x4 v_r[4]; u32x4 q_r[2]; u32x4 kt_r[2]; float dec_r = 0.f;
#define GLA_LOAD(tok0_) do { \
            if (!WITH_O) { _Pragma("unroll") for (int i = 0; i < 16; ++i) { const size_t o = (size_t)((tok0_) + 16 * tq + i) * 512 + h * 128 + kk; la_r[i] = LA[o]; k_r[i] = KB[o]; } } \
            else { _Pragma("unroll") for (int i = 0; i < 2; ++i) { const int pc = tid + 512 * i, k2 = pc >> 3, j = pc & 7; kt_r[i] = *(const u32x4*)((const unsigned char*)LA + (size_t)((tok0_) + (k2 >> 1)) * 1024 + h * 256 + (k2 & 1) * 128 + j * 16); } \
                   dec_r = DECC[(size_t)(unit * 4 + (((tok0_) - t0) >> 6)) * 128 + kk]; } \
            _Pragma("unroll") for (int i = 0; i < 4; ++i) { const int pc = tid + 512 * i, token = pc >> 5, vc = (pc & 31) * 8; v_r[i] = *(const u32x4*)(VY + (size_t)((tok0_) + token) * 1536 + 512 + h * 256 + vc); } \
            if (WITH_O) { _Pragma("unroll") for (int i = 0; i < 2; ++i) { const int pc = tid + 512 * i, token = pc >> 4, kc = (pc & 15) * 8; q_r[i] = *(const u32x4*)(Q + (size_t)((tok0_) + token) * 512 + h * 128 + kc); } } \
        } while (0)
        GLA_LOAD(t0);
        for (int c = 0; c < 4; ++c) {
            const int tok0 = t0 + 64 * c;
            if (!WITH_O) {
            float lav[16], kf[16]; float ps = 0.f;
#pragma unroll
            for (int i = 0; i < 16; ++i) { lav[i] = h2f(la_r[i]); kf[i] = bf2f(k_r[i]); ps += lav[i]; }
            __syncthreads();
            PART[tq * 128 + kk] = ps;
#pragma unroll
            for (int i = 0; i < 4; ++i) { const int pc = tid + 512 * i, token = pc >> 5, vc = (pc & 31) * 8; *(LAS u32x4*)(lds + GL_VT + token * 544 + vc * 2) = v_r[i]; }
            if (WITH_O) {
#pragma unroll
                for (int i = 0; i < 2; ++i) { const int pc = tid + 512 * i, token = pc >> 4, kc = (pc & 15) * 8; *(LAS u32x4*)(lds + GL_QS + token * 272 + kc * 2) = q_r[i]; } }
            __syncthreads();
            {
                float off = 0.f, tot = 0.f;
#pragma unroll
                for (int q = 0; q < 4; ++q) { const float pv = PART[q * 128 + kk]; tot += pv; if (q < tq) off += pv; }
                float run = off; unsigned pk[8];
#pragma unroll
                for (int i = 0; i < 16; i += 2) { run += lav[i]; const float e0 = kf[i] * __expf(tot - run); run += lav[i + 1]; const float e1 = kf[i + 1] * __expf(tot - run); pk[i >> 1] = cvt_pk_bf16(e0, e1); }
                LAS u32x4* kd = (LAS u32x4*)(lds + GL_KT + kk * 144 + tq * 32);
                kd[0] = (u32x4){pk[0], pk[1], pk[2], pk[3]}; kd[1] = (u32x4){pk[4], pk[5], pk[6], pk[7]};
                if (!WITH_O) {
                    u32x4* ke = (u32x4*)((unsigned char*)LA + (size_t)(tok0 + (kk >> 1)) * 1024 + h * 256 + (kk & 1) * 128 + tq * 32);
                    ke[0] = (u32x4){pk[0], pk[1], pk[2], pk[3]}; ke[1] = (u32x4){pk[4], pk[5], pk[6], pk[7]}; }
                if (tq == 0) { const float d = __expf(tot); DECS[kk] = d; dprod *= d; if (!WITH_O) DECC[(size_t)(unit * 4 + c) * 128 + kk] = d; }
            }
            } else {
            __syncthreads();
#pragma unroll
            for (int i = 0; i < 4; ++i) { const int pc = tid + 512 * i, token = pc >> 5, vc = (pc & 31) * 8; *(LAS u32x4*)(lds + GL_VT + token * 544 + vc * 2) = v_r[i]; }
#pragma unroll
            for (int i = 0; i < 2; ++i) { const int pc = tid + 512 * i, token = pc >> 4, kc = (pc & 15) * 8; *(LAS u32x4*)(lds + GL_QS + token * 272 + kc * 2) = q_r[i]; }
#pragma unroll
            for (int i = 0; i < 2; ++i) { const int pc = tid + 512 * i, k2 = pc >> 3, j = pc & 7; *(LAS u32x4*)(lds + GL_KT + k2 * 144 + j * 16) = kt_r[i]; }
            if (tq == 0) DECS[kk] = dec_r;
            }
            if (c < 3) GLA_LOAD(tok0 + 64);
            u32x2 sgv[4][2];
            if (WITH_O) {
#pragma unroll
                for (int tt = 0; tt < 4; ++tt)
#pragma unroll
                    for (int nt = 0; nt < 2; ++nt) sgv[tt][nt] = *(const u32x2*)(SG + (size_t)(tok0 + 16 * tt + fr) * 1024 + h * 256 + 32 * w + 16 * nt + 4 * fq); }
            __syncthreads();
#pragma unroll
            for (int mt = 0; mt < 8; ++mt) { const f32x4 dv = *(const LAS f32x4*)(DECS + 16 * mt + 4 * fq);
#pragma unroll
                for (int nt = 0; nt < 2; ++nt) S[mt][nt] = S[mt][nt] * dv; }
#pragma unroll
            for (int ks = 0; ks < 2; ++ks) { bf16x8 bV[2];
                {
                    const unsigned vaddr = (unsigned)(__SIZE_TYPE__)(lds + GL_VT) + (unsigned)((32 * ks + 8 * fq + ((lane & 15) >> 2)) * 544 + 64 * w + 8 * (lane & 3));
                    u32x2 t00, t01, t10, t11;
                    asm volatile("ds_read_b64_tr_b16 %0, %4 offset:0\n\tds_read_b64_tr_b16 %1, %4 offset:2176\n\tds_read_b64_tr_b16 %2, %4 offset:32\n\tds_read_b64_tr_b16 %3, %4 offset:2208\n\ts_waitcnt lgkmcnt(0)"
                                 : "=&v"(t00), "=&v"(t01), "=&v"(t10), "=&v"(t11) : "v"(vaddr) : "memory");
                    __builtin_amdgcn_sched_barrier(0);
                    const u32x4 b0 = (u32x4){t00[0], t00[1], t01[0], t01[1]}, b1 = (u32x4){t10[0], t10[1], t11[0], t11[1]};
                    bV[0] = __builtin_bit_cast(bf16x8, b0); bV[1] = __builtin_bit_cast(bf16x8, b1);
                }
#pragma unroll
                for (int mt = 0; mt < 8; ++mt) { const bf16x8 aK = *(const LAS bf16x8*)(lds + GL_KT + (16 * mt + fr) * 144 + ks * 64 + fq * 16);
#pragma unroll
                    for (int nt = 0; nt < 2; ++nt) S[mt][nt] = __builtin_amdgcn_mfma_f32_16x16x32_bf16(aK, bV[nt], S[mt][nt], 0, 0, 0); } }
            MFMA_SETTLE();
            if (WITH_O) {
                f32x4 O[2][4];
#pragma unroll
                for (int nt = 0; nt < 2; ++nt)
#pragma unroll
                    for (int tt = 0; tt < 4; ++tt) O[nt][tt] = (f32x4){zf, zf, zf, zf};
#pragma unroll
                for (int ks = 0; ks < 4; ++ks) { bf16x8 aS[2];
#pragma unroll
                    for (int nt = 0; nt < 2; ++nt) { const u32x4 pkd = pack8(S[2 * ks][nt], S[2 * ks + 1][nt]); aS[nt] = __builtin_bit_cast(bf16x8, pkd); }
#pragma unroll
                    for (int tt = 0; tt < 4; ++tt) { const LAS unsigned char* qp = lds + GL_QS + (16 * tt + fr) * 272 + (32 * ks + 4 * fq) * 2;
                        const u32x2 q0 = *(const LAS u32x2*)qp, q1 = *(const LAS u32x2*)(qp + 32);
                        const u32x4 qq = (u32x4){q0[0], q0[1], q1[0], q1[1]}; const bf16x8 bQ = __builtin_bit_cast(bf16x8, qq);
#pragma unroll
                        for (int nt = 0; nt < 2; ++nt) O[nt][tt] = __builtin_amdgcn_mfma_f32_16x16x32_bf16(aS[nt], bQ, O[nt][tt], 0, 0, 0); } }
                float ss[4];
#pragma unroll
                for (int tt = 0; tt < 4; ++tt) { float s = 0.f;
#pragma unroll
                    for (int nt = 0; nt < 2; ++nt)
#pragma unroll
                        for (int e = 0; e < 4; ++e) s += O[nt][tt][e] * O[nt][tt][e];
                    s += shx(s, 16, lane); s += shx(s, 32, lane); ss[tt] = s; }
                if (fq == 0) {
#pragma unroll
                    for (int tt = 0; tt < 4; ++tt) RED[w * 64 + 16 * tt + fr] = ss[tt]; }
                __syncthreads();
#pragma unroll
                for (int tt = 0; tt < 4; ++tt) { float s = 0.f;
#pragma unroll
                    for (int w2 = 0; w2 < 8; ++w2) s += RED[w2 * 64 + 16 * tt + fr];
                    const float rs = rsqrtf(s * (1.0f / 256.0f) + EPS);
#pragma unroll
                    for (int nt = 0; nt < 2; ++nt) { const int vcol = h * 256 + 32 * w + 16 * nt + 4 * fq; const size_t tok = (size_t)(tok0 + 16 * tt + fr);
                        const f32x4 gv = *(const f32x4*)(ng + vcol); const u32x2 sg = sgv[tt][nt];
                        const float y0 = O[nt][tt][0] * rs * gv[0] * bflo(sg[0]), y1 = O[nt][tt][1] * rs * gv[1] * bfhi(sg[0]);
                        const float y2 = O[nt][tt][2] * rs * gv[2] * bflo(sg[1]), y3 = O[nt][tt][3] * rs * gv[3] * bfhi(sg[1]);
                        u32x2 o; o[0] = cvt_pk_bf16(y0, y1); o[1] = cvt_pk_bf16(y2, y3);
                        *(u32x2*)(VY + tok * 1536 + 512 + vcol) = o; } }
            }
        }
#undef GLA_LOAD
        if (!WITH_O) {
#pragma unroll
            for (int mt = 0; mt < 8; ++mt)
#pragma unroll
                for (int nt = 0; nt < 2; ++nt) { u32x2 kw; kw[0] = cvt_pk_bf16(S[mt][nt][0], S[mt][nt][1]); kw[1] = cvt_pk_bf16(S[mt][nt][2], S[mt][nt][3]); KV[((size_t)unit * 16 + mt * 2 + nt) * 512 + tid] = kw; }
            if (tid < 128) DEC[unit * 128 + tid] = dprod;
        }
    }
    __syncthreads();
}
__device__ __forceinline__ void gla_scan_phase(const int WV) {
    u32x2* KV = (u32x2*)(wsp() + WS_KV); const float* DEC = (const float*)(wsp() + WS_DEC);
    for (int item = blockIdx.x * NTHR + ltid(); item < 262144; item += gridDim.x * NTHR) {
        const int tid2 = item & 511, r = (item >> 9) & 15, bh = item >> 13, b = bh >> 2, h = bh & 3;
        const int mt = r >> 1, fq = (tid2 & 63) >> 4;
        u32x2 kv[16];
#pragma unroll
        for (int sc = 0; sc < 16; ++sc) { const int unit = (b * 16 + sc) * 4 + h; kv[sc] = KV[((size_t)unit * 16 + r) * 512 + tid2]; }
        float zf; asm volatile("v_mov_b32 %0, 0" : "=v"(zf));
        f32x4 S = (f32x4){zf, zf, zf, zf};
#pragma unroll
        for (int sc = 0; sc < 16; ++sc) { const int unit = (b * 16 + sc) * 4 + h;
            u32x2 o; o[0] = cvt_pk_bf16(S[0], S[1]); o[1] = cvt_pk_bf16(S[2], S[3]);
            KV[((size_t)unit * 16 + r) * 512 + tid2] = o;
            const f32x4 d = *(const f32x4*)(DEC + unit * 128 + 16 * mt + 4 * fq);
            const f32x4 kvf = (f32x4){bflo(kv[sc][0]), bfhi(kv[sc][0]), bflo(kv[sc][1]), bfhi(kv[sc][1])};
            S = S * d + kvf; }
    }
}
#define XB_TMO      128
#define XB_XCNT(j)  (256  + 64 * (j))
#define XB_XSUB(j)  (1280 + 64 * (j))
#define XB_XGEN(j)  (2304 + 64 * (j))
#define XB_TOP      3328
#define XB_TOPGEN   3392
#define XCD_BAR_WORDS 3456
#define XB_SPIN_CAP (1u << 24)
constexpr int XB_LDS_OFF = 131072 + 64;
__device__ __forceinline__ unsigned xb_ld(unsigned* p)              { return __hip_atomic_load(p, __ATOMIC_RELAXED, __HIP_MEMORY_SCOPE_AGENT); }
__device__ __forceinline__ unsigned xb_add(unsigned* p, unsigned v) { return __hip_atomic_fetch_add(p, v, __ATOMIC_RELAXED, __HIP_MEMORY_SCOPE_AGENT); }
__device__ __forceinline__ unsigned xb_xcc_id() { return (unsigned)__builtin_amdgcn_s_getreg((3 << 11) | 20) & 0xFu; }
#define XB_SPIN(cond, bar) do { unsigned _sp = 0; while (cond) { __builtin_amdgcn_s_sleep(1); \
    if ((++_sp & 255u) == 0u) { if (xb_ld(&(bar)[XB_TMO])) break; if (_sp > XB_SPIN_CAP) { atomicAdd(&(bar)[XB_TMO], 1u); break; } } } } while (0)
__device__ __forceinline__ void xcd_barrier_complete(unsigned* bar, unsigned x, unsigned G, unsigned& nloc, unsigned& nx) {
    unsigned sum, cnt, mine, sp = 0u;
    for (;;) {
        sum = 0u; cnt = 0u; mine = 0u;
#pragma unroll
        for (unsigned j = 0; j < 16; ++j) { const unsigned c = xb_ld(&bar[XB_XCNT(j)]); sum += c; cnt += (c > 0u) ? 1u : 0u; mine = (j == x) ? c : mine; }
        if (sum == G) break;
        __builtin_amdgcn_s_sleep(1);
        if ((++sp & 255u) == 0u) { if (xb_ld(&bar[XB_TMO])) break; if (sp > XB_SPIN_CAP) { atomicAdd(&bar[XB_TMO], 1u); break; } }
    }
    nloc = mine > 0u ? mine : 1u; nx = cnt > 0u ? cnt : 1u;
}
__device__ __forceinline__ void grid_barrier(const int WV, LAS unsigned char* lds, const int G) {
    asm volatile("s_waitcnt vmcnt(0)" ::: "memory");
    __syncthreads();
    unsigned* const bar = (unsigned*)wsp();
    if (ltid() == 0) {
        volatile LAS unsigned* st = (volatile LAS unsigned*)(lds + XB_LDS_OFF);
        const unsigned x = xb_xcc_id();
        __builtin_amdgcn_s_waitcnt(0);
        unsigned nloc = st[0], nx = st[1];
        if (nloc == 0u) { xcd_barrier_complete(bar, x, (unsigned)G, nloc, nx); st[0] = nloc; st[1] = nx; }
        const unsigned old = xb_add(&bar[XB_XSUB(x)], 1u);
        const unsigned gen = old / nloc;
        if (old + 1u == (gen + 1u) * nloc) {
            __builtin_amdgcn_fence(__ATOMIC_RELEASE, "agent");
            asm volatile("s_waitcnt vmcnt(0)" ::: "memory");
            const unsigned og = xb_add(&bar[XB_TOP], 1u);
            const unsigned tg = og / nx;
            if (og + 1u == (tg + 1u) * nx) xb_add(&bar[XB_TOPGEN], 1u);
            else XB_SPIN(xb_ld(&bar[XB_TOPGEN]) == tg, bar);
            __builtin_amdgcn_fence(__ATOMIC_ACQUIRE, "agent");
            xb_add(&bar[XB_XGEN(x)], 1u);
            asm volatile("s_waitcnt vmcnt(0)" ::: "memory");
        } else {
            XB_SPIN(xb_ld(&bar[XB_XGEN(x)]) == gen, bar);
            __builtin_amdgcn_fence(__ATOMIC_ACQUIRE, "agent");
            asm volatile("s_waitcnt vmcnt(0)" ::: "memory");
        }
    }
    __syncthreads();
}
#ifdef PROBE_BAR
#define GSYNC() do { grid_barrier(WV, lds, G); grid_barrier(WV, lds, G); } while (0)
#else
#define GSYNC() grid_barrier(WV, lds, G)
#endif

__global__ void __launch_bounds__(NTHR, 2) fwd_megakernel(Args a_unused) {
    extern __shared__ __attribute__((aligned(16))) unsigned char lds_raw[];
    LAS unsigned char* lds = (LAS unsigned char*)lds_raw;
    {
        unsigned* const bz = (unsigned*)wsp();
        if (blockIdx.x == 0) { for (int i = threadIdx.x; i < 4096; i += NTHR) __hip_atomic_store(bz + i, 0u, __ATOMIC_RELAXED, __HIP_MEMORY_SCOPE_AGENT); }
        __threadfence();
    }
    cg::this_grid().sync();
    int WV = __builtin_amdgcn_readfirstlane(threadIdx.x >> 6); asm volatile("" : "+s"(WV));
    const int G = gridDim.x, bid = blockIdx.x;
#define ws wsp()
    { unsigned* const bar0 = (unsigned*)wsp(); if (ltid() == 0) { volatile LAS unsigned* st = (volatile LAS unsigned*)(lds + XB_LDS_OFF); st[0] = 0u; st[1] = 0u; (void)xb_add(&bar0[XB_XCNT(xb_xcc_id())], 1u); } }
    __syncthreads();
#define XN ((bf16_t*)(ws + WS_XN))
    for (int L = 0; L < DEPTH; ++L) {
        prep_phase(WV, L, lds);
        norm_phase<false>(WV, L == 0 ? (float*)inp(0) : outp(), inp(1) + L * 1024, XN, 0, MTOK, G >= 64 ? bid - 32 : bid, G >= 64 ? G - 32 : G);
        GSYNC();
        {
            pg8::Gemm g{(const char*)XN, (const char*)XN, (const char*)(ws + WS_WIN), MTOK, 3584, 1024, 1024, 1024, 0, 0, 1 << 30};
            pg8::StaticOrder S; S.init(MTOK, 3584, G, bid);
            EpiG1 E{L};
            pg8::gemm_phase<EpiG1>(WV, lds, g, S, E);
            la_phase(WV, L);
        }
        GSYNC();
        {
            pg8::Gemm g{(const char*)(ws + WS_U), (const char*)(ws + WS_U), (const char*)(ws + WS_BTZ), 2048, 8192, 256, 0, 256, 1, 32, 1 << 30};
            pg8::StaticOrder S; S.init(2048, 8192, G, bid);
            EpiZ E{0};
            pg8::gemm_phase<EpiZ>(WV, lds, g, S, E);
            gla_phase<false>(WV, L, lds);
        }
        GSYNC();
        s5_scan_phase(WV, lds);
        gla_scan_phase(WV);
        GSYNC();
        {
            pg8::Gemm g{(const char*)(ws + WS_U), (const char*)(ws + WS_SU) - 4 * 4096, (const char*)(ws + WS_BTY), 2048, 8192, 384, 0, 384, 1, 32, 4};
            pg8::StaticOrder S; S.init(2048, 8192, G, bid);
            EpiY E{L};
            pg8::gemm_phase<EpiY>(WV, lds, g, S, E);
            gla_phase<true>(WV, L, lds);
        }
        GSYNC();
        {
            pg8::Gemm g{(const char*)(ws + WS_U), (const char*)(ws + WS_U), (const char*)(ws + WS_WGLU), MTOK, 1024, 512, 512, 512, 0, 0, 1 << 30};
            pg8::StaticOrder S; S.init(MTOK, 1024, G, bid);
            EpiGLU E{0};
            pg8::gemm_phase<EpiGLU>(WV, lds, g, S, E);
            pg8::Gemm g2{(const char*)XN, (const char*)XN, (const char*)(ws + WS_WIN) + (size_t)3584 * 1024 * 2, MTOK, 2048, 1024, 1024, 1024, 0, 0, 1 << 30};
            pg8::StaticOrder S2; S2.init(MTOK, 2048, G, bid);
            EpiGate E2{0};
            pg8::gemm_phase<EpiGate>(WV, lds, g2, S2, E2);
        }
        GSYNC();
        {
            pg8::Gemm g{(const char*)(ws + WS_VY), (const char*)(ws + WS_VY), (const char*)(ws + WS_WMRG), MTOK, 1024, 1536, 1536, 1536, 0, 0, 1 << 30};
            pg8::StaticOrder S; S.init(MTOK, 1024, G, bid);
            EpiMerge E{0};
            pg8::gemm_phase<EpiMerge>(WV, lds, g, S, E);
        }
        GSYNC();
        {
            pg8::Gemm g{(const char*)(ws + WS_MIX), (const char*)(ws + WS_MIX), (const char*)(ws + WS_WOUT), MTOK, 1024, 1024, 1024, 1024, 0, 0, 1 << 30};
            pg8::StaticOrder S; S.init(MTOK, 1024, G, bid);
            EpiRes E{0, L == 0 ? 1 : 0};
            pg8::gemm_phase<EpiRes>(WV, lds, g, S, E);
        }
        GSYNC();
        norm_phase<false>(WV, outp(), inp(18) + L * 1024, XN, 0, MTOK, bid, G);
        GSYNC();
        {
            pg8::Gemm g{(const char*)XN, (const char*)XN, (const char*)(ws + WS_WGU), MTOK, 2 * DFF, 1024, 1024, 1024, 0, 0, 1 << 30};
            pg8::StaticOrder S; S.init(MTOK, 2 * DFF, G, bid);
            EpiGU E{0};
            pg8::gemm_phase<EpiGU>(WV, lds, g, S, E);
        }
        GSYNC();
        {
            pg8::Gemm g{(const char*)(ws + WS_H), (const char*)(ws + WS_H), (const char*)(ws + WS_WDN), MTOK, 1024, DFF, DFF, DFF, 0, 0, 1 << 30};
            pg8::StaticOrder S; S.init(MTOK, 1024, G, bid);
            EpiRes E{0, 0};
            pg8::gemm_phase<EpiRes>(WV, lds, g, S, E);
        }
        GSYNC();
    }
    norm_phase<true>(WV, outp(), inp(22), nullptr, 0, MTOK, bid, G);
}

#undef ws
#undef XN
extern "C" void kernel_launch(void* const* d_in, const int* in_sizes, int n_in, void* d_out, int out_size, void* d_ws, size_t ws_size, hipStream_t stream) {
    static int grid_blocks = 0;
    if (grid_blocks == 0) {
        if (n_in != 23 || out_size != MTOK * DM || ws_size < WS_END) { fprintf(stderr, "kernel_launch: unexpected shapes (n_in %d out %d ws %zu)\n", n_in, out_size, ws_size); grid_blocks = -1; return; }
        int dev = 0, cus = 0, per_cu = 0;
        hipGetDevice(&dev);
        hipDeviceGetAttribute(&cus, hipDeviceAttributeMultiprocessorCount, dev);
        hipFuncSetAttribute((const void*)fwd_megakernel, hipFuncAttributeMaxDynamicSharedMemorySize, LDS_BYTES);
        hipOccupancyMaxActiveBlocksPerMultiprocessor(&per_cu, (const void*)fwd_megakernel, NTHR, LDS_BYTES);
        if (per_cu < 1) per_cu = 1;
        (void)hipGetLastError();
        grid_blocks = cus * 1;
    }
    if (grid_blocks < 0) return;
    Args a{};
    for (int i = 0; i < 23; ++i) a.in[i] = (const float*)d_in[i];
    a.out = (float*)d_out; a.ws = (unsigned char*)d_ws;
    void* args[] = {&a};
    hipError_t e = hipLaunchCooperativeKernel((const void*)fwd_megakernel, dim3(grid_blocks), dim3(NTHR), args, LDS_BYTES, stream);
    if (e != hipSuccess) fprintf(stderr, "cooperative launch failed: %s (grid %d)\n", hipGetErrorString(e), grid_blocks);
}
```
